# Optimizing an MI355X kernel written in HIP

```python
import math
import jax, jax.numpy as jnp
from jax import lax
import numpy as np


D_MODEL = 1024
BATCH = 4
SEQ = 4096
DEPTH = 2

HEAD_DIM = 64
N_DIFF_HEADS = (D_MODEL // 2) // (2 * HEAD_DIM)
N_DIL_HEADS = (D_MODEL // 2) // HEAD_DIM
DIFF_WIDTH = N_DIFF_HEADS * 2 * HEAD_DIM
DIL_WIDTH = N_DIL_HEADS * HEAD_DIM
MIX_WIDTH = DIFF_WIDTH + DIL_WIDTH
D_FF = 256 * ((8 * D_MODEL // 3 + 255) // 256)
DILATED_CONFIGS = ((128, 1), (512, 4), (2048, 16))
NUM_BUCKETS = 32
MAX_DISTANCE = 2048
N_BIAS_COLS = 2 * N_DIFF_HEADS + N_DIL_HEADS
Q_BLOCK = 128
EPS = 1e-6

kernel_name = 'hybrid_diffattn_dilated_macaron'


def rmsnorm(x, g):
    x32 = x.astype(jnp.float32)
    y = x32 * lax.rsqrt(jnp.mean(x32 * x32, axis=-1, keepdims=True) + EPS)
    return (y * g.astype(jnp.float32)).astype(x.dtype)


def swiglu(x, w_gate, w_up, w_down):
    return (jax.nn.silu(x @ w_gate) * (x @ w_up)) @ w_down


def t5_bucket(dist):
    n = jnp.maximum(dist, 0)
    max_exact = NUM_BUCKETS // 2
    nf = jnp.maximum(n, 1).astype(jnp.float32)
    large = max_exact + (jnp.log(nf / max_exact) / math.log(MAX_DISTANCE / max_exact)
                         * (NUM_BUCKETS - max_exact)).astype(jnp.int32)
    large = jnp.minimum(large, NUM_BUCKETS - 1)
    return jnp.where(n < max_exact, n, large)


def lambda_init(layer):
    return 0.8 - 0.6 * math.exp(-0.3 * layer)


def diff_attention(q, k, v, lam, bias_table):
    B, H, _, S, Dh = q.shape
    nb = S // Q_BLOCK
    scale = Dh ** -0.5
    k_pos = jnp.arange(S)
    q_blocks = q.reshape(B, H, 2, nb, Q_BLOCK, Dh).transpose(3, 0, 1, 2, 4, 5)
    v32 = v.astype(jnp.float32)
    table = bias_table.astype(jnp.float32)

    def one_block(args):
        q_blk, start = args
        s = jnp.einsum('bhmqd,bhmkd->bhmqk', q_blk, k).astype(jnp.float32) * scale
        dist = (start + jnp.arange(Q_BLOCK))[:, None] - k_pos[None, :]
        bias = table[t5_bucket(dist)].transpose(2, 0, 1).reshape(H, 2, Q_BLOCK, S)
        s = jnp.where(dist >= 0, s + bias, -jnp.inf)
        p = jax.nn.softmax(s, axis=-1)
        a = p[:, :, 0] - lam * p[:, :, 1]
        return jnp.einsum('bhqk,bhkd->bhqd', a, v32)

    out = lax.map(one_block, (q_blocks, jnp.arange(nb) * Q_BLOCK))
    return out.transpose(1, 2, 0, 3, 4).reshape(B, H, S, 2 * Dh)


def dilated_branch(q, k, v, window, dil, bias_table):
    B, H, S, Dh = q.shape
    W = window // dil
    Ld = S // dil
    nb = -(-Ld // W)
    Lp = nb * W
    scale = Dh ** -0.5

    def regroup(t):
        t = t.reshape(B, H, Ld, dil, Dh).transpose(0, 1, 3, 2, 4)
        t = jnp.pad(t, ((0, 0), (0, 0), (0, 0), (0, Lp - Ld), (0, 0)))
        return t.reshape(B, H, dil, nb, W, Dh)

    def with_prev(t):
        prev = jnp.pad(t, ((0, 0), (0, 0), (0, 0), (1, 0), (0, 0), (0, 0)))[:, :, :, :nb]
        return jnp.concatenate([prev, t], axis=4)

    qg = regroup(q)
    kw = with_prev(regroup(k))
    vw = with_prev(regroup(v))
    s = jnp.einsum('bhrnqd,bhrnkd->bhrnqk', qg, kw).astype(jnp.float32) * scale
    a_idx = jnp.arange(W)[:, None]
    c_idx = jnp.arange(2 * W)[None, :]
    dist = a_idx + W - c_idx
    key_idx = jnp.arange(nb)[:, None, None] * W - W + c_idx[None]
    valid = ((dist >= 0) & (dist <= W))[None] & (key_idx >= 0)
    bias = bias_table.astype(jnp.float32)[t5_bucket(dist * dil)].transpose(2, 0, 1)
    s = jnp.where(valid, s + bias[None, :, None, None], -jnp.inf)
    m = jnp.max(s, axis=-1)
    e = jnp.exp(s - m[..., None])
    l = jnp.sum(e, axis=-1)
    o = jnp.einsum('bhrnqk,bhrnkd->bhrnqd', e, vw.astype(jnp.float32)) / l[..., None]

    def restore(t):
        tail = t.shape[5:]
        t = t.reshape((B, H, dil, Lp) + tail)[:, :, :, :Ld]
        t = jnp.moveaxis(t, 2, 3)
        return t.reshape((B, H, S) + tail)

    return restore(o), restore(m), restore(l)


def dilated_attention(q, k, v, bias_table):
    outs = [dilated_branch(q, k, v, w, d, bias_table) for (w, d) in DILATED_CONFIGS]
    m_all = jnp.stack([br[1] for br in outs])
    l_all = jnp.stack([br[2] for br in outs])
    o_all = jnp.stack([br[0] for br in outs])
    wts = l_all * jnp.exp(m_all - jnp.max(m_all, axis=0, keepdims=True))
    wts = wts / jnp.sum(wts, axis=0, keepdims=True)
    return jnp.sum(wts[..., None] * o_all, axis=0)


def token_mixer(h, w_in, w_out, lq1, lk1, lq2, lk2, subln_gain, rel_bias, layer):
    B, S, _ = h.shape
    proj = h @ w_in
    qa, ka, va, qb, kb, vb = jnp.split(
        proj, [DIFF_WIDTH, 2 * DIFF_WIDTH, 3 * DIFF_WIDTH,
               3 * DIFF_WIDTH + DIL_WIDTH, 3 * DIFF_WIDTH + 2 * DIL_WIDTH], axis=-1)
    qa = qa.reshape(B, S, N_DIFF_HEADS, 2, HEAD_DIM).transpose(0, 2, 3, 1, 4)
    ka = ka.reshape(B, S, N_DIFF_HEADS, 2, HEAD_DIM).transpose(0, 2, 3, 1, 4)
    va = va.reshape(B, S, N_DIFF_HEADS, 2 * HEAD_DIM).transpose(0, 2, 1, 3)
    lam0 = lambda_init(layer)
    f32 = jnp.float32
    lam = (jnp.exp(jnp.sum(lq1.astype(f32) * lk1.astype(f32)))
           - jnp.exp(jnp.sum(lq2.astype(f32) * lk2.astype(f32))) + lam0)
    oa = diff_attention(qa, ka, va, lam, rel_bias[:, :2 * N_DIFF_HEADS])
    oa = rmsnorm(oa, subln_gain) * (1.0 - lam0)
    oa = oa.transpose(0, 2, 1, 3).reshape(B, S, DIFF_WIDTH)
    qb = qb.reshape(B, S, N_DIL_HEADS, HEAD_DIM).transpose(0, 2, 1, 3)
    kb = kb.reshape(B, S, N_DIL_HEADS, HEAD_DIM).transpose(0, 2, 1, 3)
    vb = vb.reshape(B, S, N_DIL_HEADS, HEAD_DIM).transpose(0, 2, 1, 3)
    ob = dilated_attention(qb, kb, vb, rel_bias[:, 2 * N_DIFF_HEADS:])
    ob = ob.transpose(0, 2, 1, 3).reshape(B, S, DIL_WIDTH)
    mixed = jnp.concatenate([oa, ob], axis=-1).astype(h.dtype)
    return mixed @ w_out


def setup_inputs(seed: int = 0) -> dict:
    key = jax.random.key(seed)
    ks = jax.random.split(key, 20)
    f32 = jnp.float32
    nrm = lambda k, shape, scale: jax.random.normal(k, shape, f32) * scale
    gain = lambda k, shape: 1.0 + 0.05 * jax.random.normal(k, shape, f32)
    return {
        'x': jax.random.normal(ks[0], (BATCH, SEQ, D_MODEL), f32),
        'ffn1_norm': gain(ks[1], (DEPTH, D_MODEL)),
        'ffn1_w_gate': nrm(ks[2], (DEPTH, D_MODEL, D_FF), D_MODEL ** -0.5),
        'ffn1_w_up': nrm(ks[3], (DEPTH, D_MODEL, D_FF), D_MODEL ** -0.5),
        'ffn1_w_down': nrm(ks[4], (DEPTH, D_FF, D_MODEL), D_FF ** -0.5),
        'mix_norm': gain(ks[5], (DEPTH, D_MODEL)),
        'w_in': nrm(ks[6], (DEPTH, D_MODEL, 3 * MIX_WIDTH), D_MODEL ** -0.5),
        'lambda_q1': nrm(ks[7], (DEPTH, HEAD_DIM), 0.1),
        'lambda_k1': nrm(ks[8], (DEPTH, HEAD_DIM), 0.1),
        'lambda_q2': nrm(ks[9], (DEPTH, HEAD_DIM), 0.1),
        'lambda_k2': nrm(ks[10], (DEPTH, HEAD_DIM), 0.1),
        'subln_gain': gain(ks[11], (DEPTH, 2 * HEAD_DIM)),
        'w_out': nrm(ks[12], (DEPTH, MIX_WIDTH, D_MODEL), MIX_WIDTH ** -0.5),
        'ffn2_norm': gain(ks[13], (DEPTH, D_MODEL)),
        'ffn2_w_gate': nrm(ks[14], (DEPTH, D_MODEL, D_FF), D_MODEL ** -0.5),
        'ffn2_w_up': nrm(ks[15], (DEPTH, D_MODEL, D_FF), D_MODEL ** -0.5),
        'ffn2_w_down': nrm(ks[16], (DEPTH, D_FF, D_MODEL), D_FF ** -0.5),
        'rel_bias': nrm(ks[17], (NUM_BUCKETS, N_BIAS_COLS), 0.3),
        'final_norm': gain(ks[18], (D_MODEL,)),
    }


def reference(x, ffn1_norm, ffn1_w_gate, ffn1_w_up, ffn1_w_down, mix_norm, w_in,
              lambda_q1, lambda_k1, lambda_q2, lambda_k2, subln_gain, w_out,
              ffn2_norm, ffn2_w_gate, ffn2_w_up, ffn2_w_down, rel_bias, final_norm):
    for layer in range(DEPTH):
        x = x + 0.5 * swiglu(rmsnorm(x, ffn1_norm[layer]),
                             ffn1_w_gate[layer], ffn1_w_up[layer], ffn1_w_down[layer])
        x = x + token_mixer(rmsnorm(x, mix_norm[layer]), w_in[layer], w_out[layer],
                            lambda_q1[layer], lambda_k1[layer], lambda_q2[layer], lambda_k2[layer],
                            subln_gain[layer], rel_bias, layer)
        x = x + 0.5 * swiglu(rmsnorm(x, ffn2_norm[layer]),
                             ffn2_w_gate[layer], ffn2_w_up[layer], ffn2_w_down[layer])
    return rmsnorm(x, final_norm)
```

```cpp
#include <hip/hip_runtime.h>
#include <cstdio>
#include <cstdint>
#include <cmath>

constexpr int BATCH = 4, SEQ = 4096, DM = 1024, DEPTH = 2, DFF = 2816, NQKV = 3072;
constexpr int M = BATCH * SEQ;
constexpr float EPS = 1e-6f;
constexpr float LOG2E = 1.4426950408889634f;
constexpr float C2 = 0.125f * LOG2E;
constexpr int COL_QA = 0, COL_KA = 512, COL_VA = 1024, COL_QB = 1536, COL_KB = 2048, COL_VB = 2560;

typedef unsigned short bf16;
typedef unsigned v4u __attribute__((ext_vector_type(4)));
typedef unsigned v2u __attribute__((ext_vector_type(2)));
typedef float f32x4 __attribute__((ext_vector_type(4)));

constexpr size_t MiB = 1u << 20;
constexpr size_t WS_CTL = 0, CTL_ZERO_BYTES = 1 * MiB;
constexpr size_t WS_BT = 1 * MiB;
constexpr size_t WS_LAM = WS_BT + 16 * 4096 * 4;
constexpr size_t WS_SS = WS_LAM + 4096;
constexpr size_t WS_W = 2 * MiB;
constexpr size_t W_GU1 = 0, W_D1 = W_GU1 + (size_t)2 * DFF * DM, W_IN = W_D1 + (size_t)DM * DFF, W_OUT = W_IN + (size_t)NQKV * DM,
                 W_GU2 = W_OUT + (size_t)DM * DM, W_D2 = W_GU2 + (size_t)2 * DFF * DM, W_LAYER = W_D2 + (size_t)DM * DFF;
constexpr size_t WS_XB = 84 * MiB;
constexpr size_t WS_OD = WS_XB;
constexpr size_t WS_HQKV = 116 * MiB;
constexpr size_t WS_MIX = 212 * MiB;
constexpr size_t WS_END = 244 * MiB;
static_assert(WS_W + 2 * W_LAYER * 2 <= WS_XB, "weights fit");
static_assert(WS_SS + (size_t)M * 16 <= WS_W, "misc fits");

__device__ __forceinline__ unsigned f2bf(float f) { unsigned u = __builtin_bit_cast(unsigned, f); return (u + 0x7fffu + ((u >> 16) & 1u)) >> 16; }
__device__ __forceinline__ unsigned pk2(float lo, float hi) { return f2bf(lo) | (f2bf(hi) << 16); }
__device__ __forceinline__ float bf2f(unsigned h) { return __builtin_bit_cast(float, h << 16); }
__device__ __forceinline__ float wave_sum(float v) {
#pragma unroll
    for (int o = 1; o < 64; o <<= 1) v += __shfl_xor(v, o);
    return v;
}
__device__ __forceinline__ float wave_max(float v) {
#pragma unroll
    for (int o = 1; o < 64; o <<= 1) v = fmaxf(v, __shfl_xor(v, o));
    return v;
}

__device__ __forceinline__ int t5_bucket(int d) {
    const int st[16] = {16, 22, 30, 40, 54, 73, 99, 134, 182, 246, 332, 450, 609, 825, 1117, 1513};
    if (d < 16) return d < 0 ? 0 : d;
    int b = 16;
#pragma unroll
    for (int i = 1; i < 16; ++i) b += (d >= st[i]) ? 1 : 0;
    return b;
}
__global__ void k_bias_tables(const float* rel_bias, float* BT) {
    const int i = blockIdx.x * blockDim.x + threadIdx.x; if (i >= 16 * 4096) return;
    const int c = i >> 12, d = i & 4095;
    float v = LOG2E * rel_bias[t5_bucket(d) * 16 + c];
    if (c >= 8) { const int mult = (d <= 128 ? 1 : 0) + ((d % 4 == 0 && d <= 512) ? 1 : 0) + ((d % 16 == 0 && d <= 2048) ? 1 : 0);
        v = mult == 0 ? -INFINITY : v + log2f((float)mult); }
    BT[i] = v;
}
__global__ void k_lambda(const float* q1, const float* k1, const float* q2, const float* k2, float* LAM) {
    const int l = blockIdx.x, lane = threadIdx.x;
    const float a = wave_sum(q1[l * 64 + lane] * k1[l * 64 + lane]), b = wave_sum(q2[l * 64 + lane] * k2[l * 64 + lane]);
    const float lam0 = 0.8f - 0.6f * expf(-0.3f * (float)l);
    if (lane == 0) { LAM[l * 2 + 0] = expf(a) - expf(b) + lam0; LAM[l * 2 + 1] = 1.0f - lam0; }
}
__global__ void k_wconv(const float* W, const float* g, bf16* Wt, int K, int N, int kind) {
    const size_t i = (size_t)blockIdx.x * blockDim.x + threadIdx.x; const int kc = K / 8; if (i >= (size_t)N * kc) return;
    const int n = (int)(i % N), k0 = (int)(i / N) * 8;
    int row = n; if (kind == 1) row = (n / 128) * 256 + (n % 128); else if (kind == 2) row = (n / 128) * 256 + 128 + (n % 128);
    float sc = 1.f; if (kind == 3 && ((n >= COL_QA && n < COL_KA) || (n >= COL_QB && n < COL_KB))) sc = C2;
    float v[8];
#pragma unroll
    for (int j = 0; j < 8; ++j) v[j] = W[(size_t)(k0 + j) * N + n] * (g ? g[k0 + j] : 1.f) * sc;
    v4u o; o.x = pk2(v[0], v[1]); o.y = pk2(v[2], v[3]); o.z = pk2(v[4], v[5]); o.w = pk2(v[6], v[7]);
    *(v4u*)(Wt + (size_t)row * K + k0) = o;
}
__global__ void k_x_init(const float* x, float* X, bf16* XB, float* SS) {
    const int row = blockIdx.x * 4 + (threadIdx.x >> 6), lane = threadIdx.x & 63;
    const f32x4* xr = (const f32x4*)(x + (size_t)row * DM) + lane; float s = 0.f;
#pragma unroll
    for (int j = 0; j < 4; ++j) { const f32x4 v = xr[64 * j]; s += (v.x * v.x + v.y * v.y) + (v.z * v.z + v.w * v.w);
        ((f32x4*)(X + (size_t)row * DM) + lane)[64 * j] = v; v2u o; o.x = pk2(v.x, v.y); o.y = pk2(v.z, v.w); ((v2u*)(XB + (size_t)row * DM) + lane)[64 * j] = o; }
    s = wave_sum(s); if (lane == 0) *(f32x4*)(SS + (size_t)row * 4) = (f32x4){s, 0.f, 0.f, 0.f};
}
__global__ void k_rowss(const float* X, float* SS) {
    const int row = blockIdx.x * 4 + (threadIdx.x >> 6), lane = threadIdx.x & 63;
    const f32x4* xr = (const f32x4*)(X + (size_t)row * DM) + lane; float s = 0.f;
#pragma unroll
    for (int j = 0; j < 4; ++j) { const f32x4 v = xr[64 * j]; s += (v.x * v.x + v.y * v.y) + (v.z * v.z + v.w * v.w); }
    s = wave_sum(s); if (lane == 0) *(f32x4*)(SS + (size_t)row * 4) = (f32x4){s, 0.f, 0.f, 0.f};
}
__device__ __forceinline__ float row_rstd(const float* SS, int row) { const f32x4 s = *(const f32x4*)(SS + (size_t)row * 4); return rsqrtf(((s.x + s.y) + (s.z + s.w)) * (1.0f / DM) + EPS); }

template <int MODE>
__global__ void __launch_bounds__(256) k_ngemm(const bf16* A, int lda, const bf16* Bt, int K, const float* SS, bf16* Ob, int ldo, const float* Xin, float* Xout, bf16* XB, float alpha) {
    __shared__ float As[16][68], Bs[16][68], Us[16][68];
    const int t = threadIdx.x, tx = t & 15, ty = t >> 4, m0 = blockIdx.y * 64, n0 = blockIdx.x * 64;
    const int lr = t >> 2, lk = (t & 3) * 4;
    int brow = n0;
    if (MODE == 0) brow = (n0 / 128) * 256 + (n0 % 128);
    float acc[4][4] = {}, acu[4][4] = {};
    for (int k0 = 0; k0 < K; k0 += 16) {
        { const v2u a = *(const v2u*)(A + (size_t)(m0 + lr) * lda + k0 + lk); As[lk][lr] = bf2f(a.x & 0xffff); As[lk + 1][lr] = bf2f(a.x >> 16); As[lk + 2][lr] = bf2f(a.y & 0xffff); As[lk + 3][lr] = bf2f(a.y >> 16); }
        { const v2u b = *(const v2u*)(Bt + (size_t)(brow + lr) * K + k0 + lk); Bs[lk][lr] = bf2f(b.x & 0xffff); Bs[lk + 1][lr] = bf2f(b.x >> 16); Bs[lk + 2][lr] = bf2f(b.y & 0xffff); Bs[lk + 3][lr] = bf2f(b.y >> 16); }
        if (MODE == 0) { const v2u b = *(const v2u*)(Bt + (size_t)(brow + 128 + lr) * K + k0 + lk); Us[lk][lr] = bf2f(b.x & 0xffff); Us[lk + 1][lr] = bf2f(b.x >> 16); Us[lk + 2][lr] = bf2f(b.y & 0xffff); Us[lk + 3][lr] = bf2f(b.y >> 16); }
        __syncthreads();
#pragma unroll
        for (int k = 0; k < 16; ++k) { float a[4], b[4], u[4];
#pragma unroll
            for (int i = 0; i < 4; ++i) { a[i] = As[k][ty * 4 + i]; b[i] = Bs[k][tx * 4 + i]; if (MODE == 0) u[i] = Us[k][tx * 4 + i]; }
#pragma unroll
            for (int i = 0; i < 4; ++i)
#pragma unroll
                for (int j = 0; j < 4; ++j) { acc[i][j] += a[i] * b[j]; if (MODE == 0) acu[i][j] += a[i] * u[j]; } }
        __syncthreads();
    }
#pragma unroll
    for (int i = 0; i < 4; ++i) { const int row = m0 + ty * 4 + i;
        if (MODE == 0) { const float r = row_rstd(SS, row); float h[4];
#pragma unroll
            for (int j = 0; j < 4; ++j) { const float g = acc[i][j] * r, u = acu[i][j] * r; h[j] = g / (1.f + __expf(-g)) * u; }
            v2u o; o.x = pk2(h[0], h[1]); o.y = pk2(h[2], h[3]); *(v2u*)(Ob + (size_t)row * ldo + n0 + tx * 4) = o;
        } else if (MODE == 2) { const float r = row_rstd(SS, row);
            v2u o; o.x = pk2(acc[i][0] * r, acc[i][1] * r); o.y = pk2(acc[i][2] * r, acc[i][3] * r); *(v2u*)(Ob + (size_t)row * ldo + n0 + tx * 4) = o;
        } else { const size_t off = (size_t)row * DM + n0 + tx * 4; const f32x4 xi = *(const f32x4*)(Xin + off);
            f32x4 xo; xo.x = xi.x + alpha * acc[i][0]; xo.y = xi.y + alpha * acc[i][1]; xo.z = xi.z + alpha * acc[i][2]; xo.w = xi.w + alpha * acc[i][3];
            *(f32x4*)(Xout + off) = xo; v2u o; o.x = pk2(xo.x, xo.y); o.y = pk2(xo.z, xo.w); *(v2u*)(XB + off) = o; }
    }
}

template <int VD, bool DIL>
__global__ void __launch_bounds__(128) k_nattn(const bf16* QKV, const float* BT, bf16* O) {
    __shared__ float sc[2][4096]; __shared__ float qs[2][64];
    const int w = threadIdx.x >> 6, lane = threadIdx.x & 63, t = blockIdx.x * 2 + w, job = blockIdx.y;
    int b, qcol, kcol, vcol, ocol, c;
    if (!DIL) { const int m = job & 1, h = (job >> 1) & 3; b = job >> 3; qcol = COL_QA + h * 128 + m * 64; kcol = COL_KA + h * 128 + m * 64; vcol = COL_VA + h * 128; ocol = m * 512 + h * 128; c = h * 2 + m; }
    else { const int h = job & 7; b = job >> 3; qcol = COL_QB + h * 64; kcol = COL_KB + h * 64; vcol = COL_VB + h * 64; ocol = 512 + h * 64; c = 8 + h; }
    const size_t rb = (size_t)b * SEQ;
    qs[w][lane] = bf2f(QKV[(rb + t) * NQKV + qcol + lane]);
    __syncthreads();
    const int lo = DIL ? (t > 2048 ? t - 2048 : 0) : 0, n = t - lo + 1;
    const float* bt = BT + c * 4096;
    float mx = -INFINITY;
    for (int kk = lane; kk < n; kk += 64) { const int k = lo + kk; const v4u* kr = (const v4u*)(QKV + (rb + k) * NQKV + kcol); float s = 0.f;
#pragma unroll
        for (int j = 0; j < 8; ++j) { const v4u u = kr[j]; const float* q = &qs[w][j * 8];
            s += q[0] * bf2f(u.x & 0xffff) + q[1] * bf2f(u.x >> 16) + q[2] * bf2f(u.y & 0xffff) + q[3] * bf2f(u.y >> 16) + q[4] * bf2f(u.z & 0xffff) + q[5] * bf2f(u.z >> 16) + q[6] * bf2f(u.w & 0xffff) + q[7] * bf2f(u.w >> 16); }
        s += bt[t - k]; sc[w][kk] = s; mx = fmaxf(mx, s); }
    mx = wave_max(mx); float l = 0.f;
    for (int kk = lane; kk < n; kk += 64) { const float p = exp2f(sc[w][kk] - mx); sc[w][kk] = p; l += p; }
    l = wave_sum(l);
    __syncthreads();
    const float il = 1.f / l;
    if (VD == 128) { float o0 = 0.f, o1 = 0.f;
        for (int kk = 0; kk < n; ++kk) { const float p = sc[w][kk]; const unsigned u = *(const unsigned*)(QKV + (rb + lo + kk) * NQKV + vcol + 2 * lane); o0 += p * bf2f(u & 0xffff); o1 += p * bf2f(u >> 16); }
        *(unsigned*)(O + (rb + t) * DM + ocol + 2 * lane) = pk2(o0 * il, o1 * il);
    } else { float o0 = 0.f;
        for (int kk = 0; kk < n; ++kk) { const float p = sc[w][kk]; o0 += p * bf2f(QKV[(rb + lo + kk) * NQKV + vcol + lane]); }
        O[(rb + t) * DM + ocol + lane] = (bf16)f2bf(o0 * il); }
}
__global__ void k_combine(const bf16* OD, const float* LAM, const float* gain, bf16* MIX) {
    const int item = blockIdx.x * 4 + (threadIdx.x >> 6), lane = threadIdx.x & 63, row = item >> 2, h = item & 3;
    const float lam = LAM[0], oml = LAM[1];
    const bf16* o1 = OD + (size_t)row * DM + h * 128, *o2 = o1 + 512;
    const float d0 = bf2f(o1[lane]) - lam * bf2f(o2[lane]), d1 = bf2f(o1[lane + 64]) - lam * bf2f(o2[lane + 64]);
    const float r = rsqrtf(wave_sum(d0 * d0 + d1 * d1) * (1.0f / 128.0f) + EPS) * oml;
    MIX[(size_t)row * DM + h * 128 + lane] = (bf16)f2bf(d0 * r * gain[lane]); MIX[(size_t)row * DM + h * 128 + lane + 64] = (bf16)f2bf(d1 * r * gain[lane + 64]);
}
__global__ void k_final(float* X, const float* g) {
    const int row = blockIdx.x * 4 + (threadIdx.x >> 6), lane = threadIdx.x & 63;
    f32x4* xr = (f32x4*)(X + (size_t)row * DM) + lane; f32x4 v[4]; float s = 0.f;
#pragma unroll
    for (int j = 0; j < 4; ++j) { v[j] = xr[64 * j]; s += (v[j].x * v[j].x + v[j].y * v[j].y) + (v[j].z * v[j].z + v[j].w * v[j].w); }
    const float r = rsqrtf(wave_sum(s) * (1.0f / DM) + EPS);
#pragma unroll
    for (int j = 0; j < 4; ++j) { const f32x4 gg = ((const f32x4*)g + lane)[64 * j]; xr[64 * j] = (f32x4){v[j].x * r * gg.x, v[j].y * r * gg.y, v[j].z * r * gg.z, v[j].w * r * gg.w}; }
}

extern "C" void kernel_launch(void* const* d_in, const int* in_sizes, int n_in, void* d_out, int out_size, void* d_ws, size_t ws_size, hipStream_t stream) {
    if (n_in != 19 || in_sizes[0] != M * DM || out_size != M * DM || ws_size < WS_END) { fprintf(stderr, "kernel_launch: unexpected shapes (n_in %d, ws %zu)\n", n_in, ws_size); return; }
    const float* in[19]; for (int i = 0; i < 19; ++i) in[i] = (const float*)d_in[i];
    unsigned char* ws = (unsigned char*)d_ws; float* X = (float*)d_out;
    float* BT = (float*)(ws + WS_BT); float* LAM = (float*)(ws + WS_LAM); float* SS = (float*)(ws + WS_SS);
    bf16* W = (bf16*)(ws + WS_W); bf16* XB = (bf16*)(ws + WS_XB); bf16* OD = (bf16*)(ws + WS_OD); bf16* HQ = (bf16*)(ws + WS_HQKV); bf16* MIX = (bf16*)(ws + WS_MIX);
    k_bias_tables<<<16 * 4096 / 256, 256, 0, stream>>>(in[17], BT);
    k_lambda<<<DEPTH, 64, 0, stream>>>(in[7], in[8], in[9], in[10], LAM);
    auto wconv = [&](const float* Wsrc, const float* g, bf16* dst, int K, int N, int kind) { const size_t n = (size_t)N * (K / 8); k_wconv<<<(unsigned)((n + 255) / 256), 256, 0, stream>>>(Wsrc, g, dst, K, N, kind); };
    for (int l = 0; l < DEPTH; ++l) { bf16* Wl = W + l * W_LAYER;
        wconv(in[2] + (size_t)l * DM * DFF, in[1] + l * DM, Wl + W_GU1, DM, DFF, 1); wconv(in[3] + (size_t)l * DM * DFF, in[1] + l * DM, Wl + W_GU1, DM, DFF, 2);
        wconv(in[4] + (size_t)l * DFF * DM, nullptr, Wl + W_D1, DFF, DM, 0);
        wconv(in[6] + (size_t)l * DM * NQKV, in[5] + l * DM, Wl + W_IN, DM, NQKV, 3);
        wconv(in[12] + (size_t)l * DM * DM, nullptr, Wl + W_OUT, DM, DM, 0);
        wconv(in[14] + (size_t)l * DM * DFF, in[13] + l * DM, Wl + W_GU2, DM, DFF, 1); wconv(in[15] + (size_t)l * DM * DFF, in[13] + l * DM, Wl + W_GU2, DM, DFF, 2);
        wconv(in[16] + (size_t)l * DFF * DM, nullptr, Wl + W_D2, DFF, DM, 0); }
    k_x_init<<<M / 4, 256, 0, stream>>>(in[0], X, XB, SS);
    for (int l = 0; l < DEPTH; ++l) { bf16* Wl = W + l * W_LAYER;
        k_ngemm<0><<<dim3(DFF / 64, M / 64), 256, 0, stream>>>(XB, DM, Wl + W_GU1, DM, SS, HQ, DFF, nullptr, nullptr, nullptr, 0.f);
        k_ngemm<1><<<dim3(DM / 64, M / 64), 256, 0, stream>>>(HQ, DFF, Wl + W_D1, DFF, nullptr, nullptr, 0, X, X, XB, 0.5f);
        k_rowss<<<M / 4, 256, 0, stream>>>(X, SS);
        k_ngemm<2><<<dim3(NQKV / 64, M / 64), 256, 0, stream>>>(XB, DM, Wl + W_IN, DM, SS, HQ, NQKV, nullptr, nullptr, nullptr, 0.f);
        k_nattn<128, false><<<dim3(SEQ / 2, 32), 128, 0, stream>>>(HQ, BT, OD);
        k_nattn<64, true><<<dim3(SEQ / 2, 32), 128, 0, stream>>>(HQ, BT, MIX);
        k_combine<<<M * 4 / 4, 256, 0, stream>>>(OD, LAM + 2 * l, in[11] + l * 128, MIX);
        k_ngemm<1><<<dim3(DM / 64, M / 64), 256, 0, stream>>>(MIX, DM, Wl + W_OUT, DM, nullptr, nullptr, 0, X, X, XB, 1.0f);
        k_rowss<<<M / 4, 256, 0, stream>>>(X, SS);
        k_ngemm<0><<<dim3(DFF / 64, M / 64), 256, 0, stream>>>(XB, DM, Wl + W_GU2, DM, SS, HQ, DFF, nullptr, nullptr, nullptr, 0.f);
        k_ngemm<1><<<dim3(DM / 64, M / 64), 256, 0, stream>>>(HQ, DFF, Wl + W_D2, DFF, nullptr, nullptr, 0, X, X, XB, 0.5f);
        k_rowss<<<M / 4, 256, 0, stream>>>(X, SS);
    }
    k_final<<<M / 4, 256, 0, stream>>>(X, in[18]);
}
```

```cpp
#include <hip/hip_runtime.h>
#include <cstdio>
#include <cstdint>
#include <cmath>

constexpr int BATCH = 4, SEQ = 4096, DM = 1024, DEPTH = 2, DFF = 2816, NQKV = 3072;
constexpr int M = BATCH * SEQ;
constexpr float EPS = 1e-6f;
constexpr float LOG2E = 1.4426950408889634f;
constexpr float C2 = 0.125f * LOG2E;
constexpr int COL_QA = 0, COL_KA = 512, COL_VA = 1024, COL_QB = 1536, COL_KB = 2048, COL_VB = 2560;

typedef unsigned short bf16;
typedef unsigned v4u __attribute__((ext_vector_type(4)));
typedef unsigned v2u __attribute__((ext_vector_type(2)));

constexpr size_t MiB = 1u << 20;
constexpr size_t WS_CTL = 0, CTL_ZERO_BYTES = 1 * MiB;
constexpr int CW_BAR = 4096;
constexpr size_t WS_BT = 1 * MiB;
constexpr size_t WS_LAM = WS_BT + 16 * 4096 * 4;
constexpr size_t WS_SS = WS_LAM + 4096;
constexpr size_t WS_W = 2 * MiB;
constexpr size_t W_GU1 = 0, W_D1 = W_GU1 + (size_t)2 * DFF * DM, W_IN = W_D1 + (size_t)DM * DFF, W_OUT = W_IN + (size_t)NQKV * DM,
                 W_GU2 = W_OUT + (size_t)DM * DM, W_D2 = W_GU2 + (size_t)2 * DFF * DM, W_LAYER = W_D2 + (size_t)DM * DFF;
constexpr size_t WS_XB = 84 * MiB;
constexpr size_t WS_OD = WS_XB;
constexpr size_t WS_HQKV = 116 * MiB;
constexpr size_t WS_MIX = 212 * MiB;
constexpr size_t WS_END = 244 * MiB;
static_assert(WS_W + 2 * W_LAYER * 2 <= WS_XB, "weights fit");
static_assert(WS_SS + (size_t)M * 16 <= WS_W, "misc fits");

constexpr int LDS_BYTES = 163840;
constexpr int LDSCTL_OFF = LDS_BYTES - 512, MISC_OFF = LDSCTL_OFF + 64;
constexpr int EPI_OFF = LDSCTL_OFF - 4096;
constexpr int QS_OFF = EPI_OFF - 2048;
constexpr int RING_OFF = 0, RING_BYTES = QS_OFF;
static_assert(RING_BYTES >= 131072, "LDS map");
constexpr int CW_Q = 16384;
constexpr int NWAVES = 8;

__device__ __forceinline__ unsigned f2bf(float f) { unsigned u = __builtin_bit_cast(unsigned, f); return (u + 0x7fffu + ((u >> 16) & 1u)) >> 16; }
__device__ __forceinline__ unsigned pk2(float lo, float hi) { return f2bf(lo) | (f2bf(hi) << 16); }
__device__ __forceinline__ float bf2f(unsigned h) { return __builtin_bit_cast(float, h << 16); }
__device__ __forceinline__ float wave_sum(float v) {
#pragma unroll
    for (int o = 1; o < 64; o <<= 1) v += __shfl_xor(v, o);
    return v;
}
__device__ __forceinline__ float wave_max(float v) {
#pragma unroll
    for (int o = 1; o < 64; o <<= 1) v = fmaxf(v, __shfl_xor(v, o));
    return v;
}
namespace pg8 {
#define PG8_LAS __attribute__((address_space(3)))
typedef unsigned short bf16_t;
typedef short bf16x8 __attribute__((ext_vector_type(8)));
typedef float f32x4 __attribute__((ext_vector_type(4)));
typedef unsigned u32x4 __attribute__((ext_vector_type(4)));
constexpr int BM = 256, BK = 64, HALF = 128, HTB = HALF * BK * 2  , STAGE_BYTES = 8 * HTB, NXCD = 8, WGM = 8;

__host__ __device__ __forceinline__ int lds_byte(int r, int c) { const int st = (r >> 4) * 2 + (c >> 5), rr = r & 15, cc = c & 31, ob = rr * 64 + cc * 2; return st * 1024 + (ob ^ (((ob >> 9) & 1) << 5)); }
__host__ __device__ __forceinline__ void stage_rc(int b, int& R, int& C) { const int st = b / 1024, sb = b % 1024, swz = sb ^ (((sb >> 9) & 1) << 5); R = (st >> 1) * 16 + swz / 64; C = (st & 1) * 32 + (swz % 64) / 2; }
__host__ __device__ __forceinline__ int perm32(int rho) { const int n = rho >> 4, i = rho & 15; return 8 * (i >> 2) + 4 * n + (i & 3); }

struct Unit { int pm, pn; };
struct Gemm { const bf16_t* A; const bf16_t* Bt; int M, N, K; };

struct StaticOrder {
    int nM, nN, nwg, G, c;
    __host__ __device__ void init(int M, int N, int G_, int c_) { nM = M / BM; nN = N / BM; nwg = nM * nN; G = G_; c = c_; }
    __host__ __device__ bool next(int i, Unit& u) const {
        const long L = (long)i * G + c; if (L >= nwg) return false;
        int wgid = (int)L; { const int q = nwg / NXCD, r = nwg % NXCD, xcd = wgid % NXCD, off = wgid / NXCD; wgid = (xcd < r ? xcd * (q + 1) : r * (q + 1) + (xcd - r) * q) + off; }
        const int nig = WGM * nN, gid = wgid / nig, fm = gid * WGM, gsz = (nM - fm) < WGM ? (nM - fm) : WGM;
        u.pm = fm + ((wgid % nig) % gsz); u.pn = (wgid % nig) / gsz; return true;
    }
    __device__ __forceinline__ void a_ready(const Unit&) const {}
    __device__ __forceinline__ void done(const Unit&) const {}
};

__device__ __forceinline__ unsigned cvt_pk_bf16(float lo, float hi) { unsigned r; asm volatile("v_cvt_pk_bf16_f32 %0, %1, %2" : "=v"(r) : "v"(lo), "v"(hi)); return r; }
typedef float f32x2 __attribute__((ext_vector_type(2)));
typedef unsigned u32x2w __attribute__((ext_vector_type(2)));
__device__ __forceinline__ __amdgpu_buffer_rsrc_t wt_rsrc(const void* base, unsigned bytes) { return __builtin_amdgcn_make_buffer_rsrc((void*)base, 0, (int)bytes, 0x00020000); }
__device__ __forceinline__ void wt_store16(__amdgpu_buffer_rsrc_t rs, unsigned byte_off, u32x4 v) { __builtin_amdgcn_raw_buffer_store_b128(v, rs, byte_off, 0, 16); }
__device__ __forceinline__ void wt_store8(__amdgpu_buffer_rsrc_t rs, unsigned byte_off, u32x2w v) { __builtin_amdgcn_raw_buffer_store_b64(v, rs, byte_off, 0, 16); }
__device__ __forceinline__ float rstd_of(const float* SS, int row) { const f32x4 s = *(const f32x4*)(SS + (size_t)row * 4); return __builtin_amdgcn_rsqf(((s[0] + s[1]) + (s[2] + s[3])) * (1.0f / 1024.0f) + 1e-6f); }
__device__ __forceinline__ float silu_mul(float g, float u) { return g * u * __builtin_amdgcn_rcpf(1.0f + __builtin_amdgcn_exp2f(-1.4426950408889634f * g)); }
struct EpiGU {
    static constexpr bool PERM = true, AFTER_DRAIN = false;
    bf16_t* H; int ldh; const float* SS;
    __device__ __forceinline__ void operator()(const f32x4 (&acc)[2][2][4][2], const Unit& u, int wr, int wc, int fr, int fq, int wid, int lane) const {
        const int row0 = u.pm * BM + wr * 64 + fr, col0 = u.pn * HALF + wc * 32 + 8 * fq;
        const __amdgpu_buffer_rsrc_t rs = wt_rsrc(H, 16384u * 2816u * 2u);
        float rs_[2][4];
#pragma unroll
        for (int ai = 0; ai < 2; ++ai)
#pragma unroll
            for (int m = 0; m < 4; ++m) rs_[ai][m] = rstd_of(SS, row0 + ai * HALF + m * 16);
#pragma unroll
        for (int ai = 0; ai < 2; ++ai)
#pragma unroll
            for (int m = 0; m < 4; ++m) { const float r = rs_[ai][m]; const f32x4 g0 = acc[ai][0][m][0] * r, g1 = acc[ai][0][m][1] * r, u0 = acc[ai][1][m][0] * r, u1 = acc[ai][1][m][1] * r;
                u32x4 w; w.x = cvt_pk_bf16(silu_mul(g0[0], u0[0]), silu_mul(g0[1], u0[1])); w.y = cvt_pk_bf16(silu_mul(g0[2], u0[2]), silu_mul(g0[3], u0[3]));
                w.z = cvt_pk_bf16(silu_mul(g1[0], u1[0]), silu_mul(g1[1], u1[1])); w.w = cvt_pk_bf16(silu_mul(g1[2], u1[2]), silu_mul(g1[3], u1[3]));
                wt_store16(rs, (unsigned)(((row0 + ai * HALF + m * 16) * ldh + col0) * 2), w); }
    }
};
struct EpiQKV {
    static constexpr bool PERM = true, AFTER_DRAIN = false;
    bf16_t* O; int ldc; const float* SS;
    __device__ __forceinline__ void operator()(const f32x4 (&acc)[2][2][4][2], const Unit& u, int wr, int wc, int fr, int fq, int wid, int lane) const {
        const int row0 = u.pm * BM + wr * 64 + fr, col0 = u.pn * BM + wc * 32 + 8 * fq;
        const __amdgpu_buffer_rsrc_t ob = wt_rsrc(O, 16384u * 3072u * 2u);
        float rs[2][4];
#pragma unroll
        for (int ai = 0; ai < 2; ++ai)
#pragma unroll
            for (int m = 0; m < 4; ++m) rs[ai][m] = rstd_of(SS, row0 + ai * HALF + m * 16);
#pragma unroll
        for (int ai = 0; ai < 2; ++ai)
#pragma unroll
            for (int m = 0; m < 4; ++m) { const float r = rs[ai][m]; const unsigned rowb = (unsigned)(((row0 + ai * HALF + m * 16) * ldc + col0) * 2);
#pragma unroll
                for (int bj = 0; bj < 2; ++bj) { const f32x4 v0 = acc[ai][bj][m][0] * r, v1 = acc[ai][bj][m][1] * r;
                    u32x4 w; w.x = cvt_pk_bf16(v0[0], v0[1]); w.y = cvt_pk_bf16(v0[2], v0[3]); w.z = cvt_pk_bf16(v1[0], v1[1]); w.w = cvt_pk_bf16(v1[2], v1[3]);
                    wt_store16(ob, rowb + bj * HALF * 2, w); } }
    }
};
struct EpiRes {
    static constexpr bool PERM = false, AFTER_DRAIN = false;
    const float* Xin; float* X; bf16_t* XB; float* SS; float alpha; PG8_LAS float* P;
    __device__ __forceinline__ void operator()(const f32x4 (&acc)[2][2][4][2], const Unit& u, int wr, int wc, int fr, int fq, int wid, int lane) const {
        typedef unsigned u32x2v __attribute__((ext_vector_type(2)));
        const int col0 = u.pn * BM + wc * 32 + 4 * fq;
        const __amdgpu_buffer_rsrc_t xr = wt_rsrc(X, 16384u * 1024u * 4u), xbr = wt_rsrc(XB, 16384u * 1024u * 2u);
#pragma unroll
        for (int ai = 0; ai < 2; ++ai)
#pragma unroll
            for (int m = 0; m < 4; ++m) { const int r = ai * HALF + wr * 64 + m * 16 + fr; const size_t off = (size_t)(u.pm * BM + r) * 1024 + col0; float ss = 0.f;
#pragma unroll
                for (int bj = 0; bj < 2; ++bj)
#pragma unroll
                    for (int n = 0; n < 2; ++n) { const size_t o2 = off + bj * HALF + n * 16; const f32x4 xi = *(const f32x4*)(Xin + o2); const f32x4 xo = xi + acc[ai][bj][m][n] * alpha;
                        wt_store16(xr, (unsigned)(o2 * 4), __builtin_bit_cast(u32x4, xo)); u32x2v w; w.x = cvt_pk_bf16(xo[0], xo[1]); w.y = cvt_pk_bf16(xo[2], xo[3]); wt_store8(xbr, (unsigned)(o2 * 2), w);
                        ss += (xo[0] * xo[0] + xo[1] * xo[1]) + (xo[2] * xo[2] + xo[3] * xo[3]); }
                ss += __shfl_xor(ss, 16); ss += __shfl_xor(ss, 32);
                if (fq == 0) P[r * 4 + wc] = ss;
                if (m & 1) asm volatile("" ::: "memory"); }
        asm volatile("s_waitcnt lgkmcnt(0)" ::: "memory"); __builtin_amdgcn_s_barrier(); asm volatile("" ::: "memory");
        if (wc == 0 && fq == 0) {
#pragma unroll
            for (int ai = 0; ai < 2; ++ai)
#pragma unroll
                for (int m = 0; m < 4; ++m) { const int r = ai * HALF + wr * 64 + m * 16 + fr; const f32x4 p = *(const PG8_LAS f32x4*)(P + r * 4);
                    SS[(size_t)(u.pm * BM + r) * 4 + u.pn] = (p[0] + p[1]) + (p[2] + p[3]); }
        }
    }
};
template <class Epi, class Sched, bool ALIGN_EPI = false, bool SP2 = false>
__device__ __forceinline__ void gemm_phase(PG8_LAS unsigned char* lds, const Gemm g, const Sched& S, const Epi& E) {
    int tid_ = threadIdx.x; asm volatile("" : "+v"(tid_));
    const int tid = tid_, wid = __builtin_amdgcn_readfirstlane(tid >> 6), lane = tid & 63, wr = wid >> 2, wc = wid & 3, fr = lane & 15, fq = lane >> 4;
    const int K = g.K, nt = K / BK;
    unsigned voffA[2], voffB[2];
#pragma unroll
    for (int i = 0; i < 2; ++i) { int R, C; stage_rc(tid * 16 + i * 8192, R, C); const int Rb = Epi::PERM ? ((R & ~31) + perm32(R & 31)) : R;
        voffA[i] = (unsigned)(R * K + C) * 2u; voffB[i] = (unsigned)(Rb * K + C) * 2u; }
    const size_t kstep = (size_t)(BK * 2);
    const size_t hstep = (size_t)HALF * K * 2;
    const size_t tstep = 2 * hstep;
    const unsigned ldsw = (unsigned)wid * 1024u;
    const int aoff = lds_byte(wr * 64 + fr, fq * 8), boff = lds_byte(wc * 32 + fr, fq * 8);
#define PG8_SA(b, h) (((b) * 2 + (h)) * HTB)
#define PG8_SB(b, h) ((4 + (b) * 2 + (h)) * HTB)
#define PG8_STAGE(bufoff, gbase, voff) do { _Pragma("unroll") for (int _i = 0; _i < 2; ++_i) \
        __builtin_amdgcn_global_load_lds((const unsigned*)((const char*)(gbase) + (voff)[_i]), (PG8_LAS unsigned*)(lds + (bufoff) + ldsw + _i * 8192), 16, 0, 0); } while (0)
#define PG8_LDA(dst, b, h) do { _Pragma("unroll") for (int m = 0; m < 4; ++m) _Pragma("unroll") for (int k = 0; k < 2; ++k) dst[m][k] = *(const PG8_LAS bf16x8*)(lds + PG8_SA(b, h) + aoff + m * 2048 + k * 1024); } while (0)
#define PG8_LDB(dst, b, h) do { _Pragma("unroll") for (int n = 0; n < 2; ++n) _Pragma("unroll") for (int k = 0; k < 2; ++k) dst[n][k] = *(const PG8_LAS bf16x8*)(lds + PG8_SB(b, h) + boff + n * 2048 + k * 1024); } while (0)
#define PG8_MMA(ai, bj, At, Bt) do { __builtin_amdgcn_s_setprio(1); _Pragma("unroll") for (int m = 0; m < 4; ++m) _Pragma("unroll") for (int n = 0; n < 2; ++n) _Pragma("unroll") for (int k = 0; k < 2; ++k) \
        acc[ai][bj][m][n] = __builtin_amdgcn_mfma_f32_16x16x32_bf16(Bt[n][k], At[m][k], acc[ai][bj][m][n], 0, 0, 0); __builtin_amdgcn_s_setprio(0); } while (0)
#define PG8_WAIT_V(n) asm volatile("s_waitcnt vmcnt(" #n ")" ::: "memory")
#define PG8_WAIT_L(n) asm volatile("s_waitcnt lgkmcnt(" #n ")" ::: "memory")
#define PG8_BAR __builtin_amdgcn_s_barrier()
#define PG8_SCHED __builtin_amdgcn_sched_barrier(0)
    Unit cur, nxt; int ui = 0;
    if (!S.next(0, cur)) return;
    f32x4 acc[2][2][4][2];
#pragma unroll
    for (int a = 0; a < 2; ++a)
#pragma unroll
        for (int b = 0; b < 2; ++b)
#pragma unroll
            for (int m = 0; m < 4; ++m)
#pragma unroll
                for (int n = 0; n < 2; ++n) acc[a][b][m][n] = (f32x4){0.f, 0.f, 0.f, 0.f};
    bf16x8 At[4][2], B0[2][2], B1[2][2];
    const char* cA = (const char*)g.A + (size_t)cur.pm * tstep; const char* cB = (const char*)g.Bt + (size_t)cur.pn * tstep;
    S.a_ready(cur);
    if constexpr (SP2) {
        PG8_STAGE(PG8_SB(0, 0), cB, voffB); PG8_STAGE(PG8_SB(0, 1), cB + hstep, voffB); PG8_STAGE(PG8_SA(0, 0), cA, voffA); PG8_STAGE(PG8_SA(0, 1), cA + hstep, voffA);
        if (wr == 1) PG8_BAR;
        PG8_WAIT_V(2); PG8_BAR;
        PG8_STAGE(PG8_SB(1, 0), cB + kstep, voffB); PG8_STAGE(PG8_SA(1, 0), cA + kstep, voffA); PG8_STAGE(PG8_SB(1, 1), cB + hstep + kstep, voffB);
        PG8_WAIT_V(6); PG8_BAR;
    } else {
        PG8_STAGE(PG8_SB(0, 0), cB, voffB); PG8_STAGE(PG8_SA(0, 0), cA, voffA); PG8_STAGE(PG8_SB(0, 1), cB + hstep, voffB); PG8_STAGE(PG8_SA(0, 1), cA + hstep, voffA);
        if (wr == 1) PG8_BAR;
        PG8_WAIT_V(4); PG8_BAR;
        PG8_STAGE(PG8_SB(1, 0), cB + kstep, voffB); PG8_STAGE(PG8_SA(1, 0), cA + kstep, voffA); PG8_STAGE(PG8_SB(1, 1), cB + hstep + kstep, voffB);
        PG8_WAIT_V(6); PG8_BAR;
    }
    for (;;) {
        const bool has_next = S.next(ui + 1, nxt);
        const char* nA = has_next ? (const char*)g.A + (size_t)nxt.pm * tstep : cA; const char* nB = has_next ? (const char*)g.Bt + (size_t)nxt.pn * tstep : cB;
        for (int t = 0; t < nt; t += 2) {
            const bool last = (t == nt - 2);
            const char* a1 = cA + (size_t)(t + 1) * kstep;
            const char* a2 = last ? nA : cA + (size_t)(t + 2) * kstep; const char* b2 = last ? nB : cB + (size_t)(t + 2) * kstep;
            const char* a3 = a2 + kstep; const char* b3 = b2 + kstep;
            if (last && has_next) S.a_ready(nxt);
            if constexpr (SP2) {
            PG8_LDB(B0, 0, 0); PG8_LDB(B1, 0, 1); PG8_SCHED; PG8_LDA(At, 0, 0); PG8_STAGE(PG8_SA(1, 1), a1 + hstep, voffA);
            PG8_WAIT_V(8); PG8_WAIT_L(0); PG8_BAR; PG8_MMA(0, 0, At, B0); PG8_MMA(0, 1, At, B1); PG8_BAR; PG8_SCHED;
            PG8_LDA(At, 0, 1); PG8_STAGE(PG8_SB(0, 0), b2, voffB); PG8_STAGE(PG8_SB(0, 1), b2 + hstep, voffB); PG8_STAGE(PG8_SA(0, 0), a2, voffA);
            PG8_WAIT_V(8); PG8_WAIT_L(0); PG8_BAR; PG8_MMA(1, 0, At, B0); PG8_MMA(1, 1, At, B1); PG8_BAR; PG8_SCHED;
            PG8_LDB(B0, 1, 0); PG8_LDB(B1, 1, 1); PG8_SCHED; PG8_LDA(At, 1, 0); PG8_STAGE(PG8_SA(0, 1), a2 + hstep, voffA);
            PG8_WAIT_V(8); PG8_WAIT_L(0); PG8_BAR; PG8_MMA(0, 0, At, B0); PG8_MMA(0, 1, At, B1); PG8_BAR; PG8_SCHED;
            PG8_LDA(At, 1, 1); PG8_STAGE(PG8_SB(1, 0), b3, voffB); PG8_STAGE(PG8_SB(1, 1), b3 + hstep, voffB); PG8_STAGE(PG8_SA(1, 0), a3, voffA);
            PG8_WAIT_V(8); PG8_WAIT_L(0); PG8_BAR; PG8_MMA(1, 0, At, B0); PG8_MMA(1, 1, At, B1); PG8_BAR; PG8_SCHED;
            } else {
            PG8_LDB(B0, 0, 0); PG8_SCHED; PG8_LDA(At, 0, 0); PG8_STAGE(PG8_SA(1, 1), a1 + hstep, voffA);
            PG8_WAIT_L(8); PG8_BAR; PG8_WAIT_L(0); PG8_MMA(0, 0, At, B0); PG8_BAR; PG8_SCHED;
            PG8_LDB(B1, 0, 1); PG8_STAGE(PG8_SB(0, 0), b2, voffB);
            PG8_BAR; PG8_WAIT_L(0); PG8_MMA(0, 1, At, B1); PG8_BAR;
            PG8_LDA(At, 0, 1); PG8_STAGE(PG8_SA(0, 0), a2, voffA);
            PG8_BAR; PG8_WAIT_L(0); PG8_MMA(1, 0, At, B0); PG8_BAR; PG8_SCHED;
            PG8_STAGE(PG8_SB(0, 1), b2 + hstep, voffB);
            PG8_WAIT_V(6); PG8_BAR; PG8_MMA(1, 1, At, B1); PG8_BAR;
            PG8_LDB(B0, 1, 0); PG8_SCHED; PG8_LDA(At, 1, 0); PG8_STAGE(PG8_SA(0, 1), a2 + hstep, voffA);
            PG8_WAIT_L(8); PG8_BAR; PG8_WAIT_L(0); PG8_MMA(0, 0, At, B0); PG8_BAR; PG8_SCHED;
            PG8_LDB(B1, 1, 1); PG8_STAGE(PG8_SB(1, 0), b3, voffB);
            PG8_BAR; PG8_WAIT_L(0); PG8_MMA(0, 1, At, B1); PG8_BAR;
            PG8_LDA(At, 1, 1); PG8_STAGE(PG8_SA(1, 0), a3, voffA);
            PG8_BAR; PG8_WAIT_L(0); PG8_MMA(1, 0, At, B0); PG8_BAR; PG8_SCHED;
            PG8_STAGE(PG8_SB(1, 1), b3 + hstep, voffB);
            PG8_WAIT_V(6); PG8_BAR; PG8_MMA(1, 1, At, B1); PG8_BAR;
            }
        }
        if constexpr (ALIGN_EPI) { if (wr == 0) PG8_BAR; }
        if constexpr (!Epi::AFTER_DRAIN) { E(acc, cur, wr, wc, fr, fq, wid, lane); S.done(cur); }
        if (!has_next) break;
#pragma unroll
        for (int a = 0; a < 2; ++a)
#pragma unroll
            for (int b = 0; b < 2; ++b)
#pragma unroll
                for (int m = 0; m < 4; ++m)
#pragma unroll
                    for (int n = 0; n < 2; ++n) acc[a][b][m][n] = (f32x4){0.f, 0.f, 0.f, 0.f};
        cur = nxt; cA = nA; cB = nB; ++ui;
        if constexpr (ALIGN_EPI) { if (wr == 1) PG8_BAR; }
    }
    PG8_WAIT_V(0);
    if constexpr (!ALIGN_EPI) { if (wr == 0) PG8_BAR; }
    PG8_BAR;
    if constexpr (Epi::AFTER_DRAIN) { E.fused(acc, cur, wr, wc, fr, fq, lds, wid, lane); S.done(cur); }
#undef PG8_SA
#undef PG8_SB
#undef PG8_STAGE
#undef PG8_LDA
#undef PG8_LDB
#undef PG8_MMA
#undef PG8_WAIT_V
#undef PG8_WAIT_L
#undef PG8_BAR
#undef PG8_SCHED
}
}
#include <hip/hip_bf16.h>
namespace attn_body {
using bf16=__hip_bfloat16;
using bf16x8=__attribute__((ext_vector_type(8)))short;
using s16x4=__attribute__((ext_vector_type(4)))short;
using f32x16=__attribute__((ext_vector_type(16)))float;
using f32x4v=__attribute__((ext_vector_type(4)))float;
using u32x4=__attribute__((ext_vector_type(4)))unsigned;
constexpr int SEQ=4096,PQ=3072,PO=1024;
constexpr int NW=8,QBLK=32,QB=QBLK*NW,KVBLK=64;
__device__ __forceinline__ int crow(int r,int hi){return (r&3)+8*(r>>2)+4*hi;}
#define SBAR() __builtin_amdgcn_sched_barrier(0)
__device__ __forceinline__ void cmask(f32x16&p0,f32x16&p1,int jb,int qrel,int hi){
  const float NEG=-INFINITY; int kb=64*jb+4*hi;
  #pragma unroll
  for(int r=0;r<16;++r){int kv=kb+(r&3)+8*(r>>2); if(kv>qrel)p0[r]=NEG; if(kv+32>qrel)p1[r]=NEG;}
}
constexpr int NSLOT=3, SLOTB=8192;
constexpr int DTOP=2176, TB_NI=DTOP+320, TB_STRIDE=TB_NI*4+16;
template<int VD> struct Lay {
  static constexpr int VSLOT=SLOTB*(VD/64), LDS_K=0, LDS_V=NSLOT*SLOTB, LDS_WS=LDS_V+NSLOT*VSLOT, LDS_OST=LDS_WS+NW*64*4, LDS_TB=LDS_OST+NW*4096, LDS_BYTES=LDS_TB+4*TB_STRIDE;
};
__device__ __forceinline__ void glds16(const void*gsrc,unsigned lds_dst){unsigned keep;
  asm volatile("s_mov_b32 %0, m0\n\ts_mov_b32 m0, %2\n\ts_nop 0\n\tglobal_load_lds_dwordx4 %1, off\n\ts_mov_b32 m0, %0":"=&s"(keep):"v"(gsrc),"s"(lds_dst):"memory");}
__device__ __forceinline__ float fsub_s(float a,float b){float r;asm("v_sub_f32_e32 %0, %1, %2":"=v"(r):"v"(a),"v"(b));return r;}
typedef float f32x2_t __attribute__((ext_vector_type(2))); typedef __bf16 bf16x2_t __attribute__((ext_vector_type(2)));
__device__ __forceinline__ unsigned cvtpk_s(float lo,float hi){f32x2_t v={lo,hi};bf16x2_t b=__builtin_convertvector(v,bf16x2_t);return __builtin_bit_cast(unsigned,b);}
#define WAIT_BAR(N) asm volatile("s_waitcnt vmcnt(" #N ") lgkmcnt(0)\n\ts_barrier":::"memory")
typedef __attribute__((address_space(3))) const char* lds_cptr;
typedef short v4i16_t __attribute__((ext_vector_type(4)));
__device__ __forceinline__ void kload8(bf16x8*kf,lds_cptr kp){
  kf[0]=*(const __attribute__((address_space(3))) bf16x8*)(kp);      kf[1]=*(const __attribute__((address_space(3))) bf16x8*)(kp+512);
  kf[2]=*(const __attribute__((address_space(3))) bf16x8*)(kp+2048); kf[3]=*(const __attribute__((address_space(3))) bf16x8*)(kp+2560);
  kf[4]=*(const __attribute__((address_space(3))) bf16x8*)(kp+4096); kf[5]=*(const __attribute__((address_space(3))) bf16x8*)(kp+4608);
  kf[6]=*(const __attribute__((address_space(3))) bf16x8*)(kp+6144); kf[7]=*(const __attribute__((address_space(3))) bf16x8*)(kp+6656);
}
__device__ __forceinline__ void kload2(bf16x8*kf,lds_cptr kp,int j){ kf[2*j]=*(const __attribute__((address_space(3))) bf16x8*)(kp+j*2048); kf[2*j+1]=*(const __attribute__((address_space(3))) bf16x8*)(kp+j*2048+512); }
__device__ __forceinline__ s16x4 vtr(lds_cptr p){ return __builtin_bit_cast(s16x4,__builtin_amdgcn_ds_read_tr16_b64_v4i16((__attribute__((address_space(3))) v4i16_t*)p)); }
__device__ __forceinline__ void bload2(f32x16&c,lds_cptr bp,int off,int g){ const f32x4v v=*(const __attribute__((address_space(3))) f32x4v*)(bp+off+32*g); c[4*g]=v[0];c[4*g+1]=v[1];c[4*g+2]=v[2];c[4*g+3]=v[3]; }
__device__ __forceinline__ void bload16(f32x16&c0,f32x16&c1,lds_cptr bp){
  #pragma unroll
  for(int g=0;g<4;++g){bload2(c0,bp,0,g);bload2(c1,bp,128,g);} }
#define MX3(a,b,c) __builtin_fmaxf(__builtin_fmaxf((a),(b)),(c))
__device__ __forceinline__ float rowmax(const f32x16&p0,const f32x16&p1){
  float a=MX3(p0[0],p0[1],p1[0]),b=MX3(p0[2],p0[3],p1[1]);a=MX3(a,p1[2],p1[3]);
  #pragma unroll
  for(int r=4;r<16;r+=4){a=MX3(a,p0[r],p0[r+1]);b=MX3(b,p0[r+2],p0[r+3]);a=MX3(a,p1[r],p1[r+1]);b=MX3(b,p1[r+2],p1[r+3]);}
  float m=__builtin_fmaxf(a,b);
  auto rr=__builtin_amdgcn_permlane32_swap(__float_as_uint(m),__float_as_uint(m),false,false);
  return __builtin_fmaxf(__uint_as_float(rr[0]),__uint_as_float(rr[1]));
}
template<int ND> __device__ __forceinline__ void pv(f32x16*o,int vb,bf16x8 pa0,bf16x8 pa1,bf16x8 pa2,bf16x8 pa3){
  #pragma unroll
  for(int d0=0;d0<ND;++d0){s16x4 lo[4],hi[4];
    #pragma unroll
    for(int ks=0;ks<4;++ks){
      asm volatile("ds_read_b64_tr_b16 %0,%1 offset:%c2":"=&v"(lo[ks]):"v"(vb),"i"(d0*4096+ks*1024):"memory");
      asm volatile("ds_read_b64_tr_b16 %0,%1 offset:%c2":"=&v"(hi[ks]):"v"(vb),"i"(d0*4096+ks*1024+512):"memory");}
    asm volatile("s_waitcnt lgkmcnt(0)":::"memory");SBAR();
    #define PK(k) (bf16x8){lo[k][0],lo[k][1],lo[k][2],lo[k][3],hi[k][0],hi[k][1],hi[k][2],hi[k][3]}
    o[d0]=__builtin_amdgcn_mfma_f32_32x32x16_bf16(pa0,PK(0),o[d0],0,0,0);
    o[d0]=__builtin_amdgcn_mfma_f32_32x32x16_bf16(pa1,PK(1),o[d0],0,0,0);
    o[d0]=__builtin_amdgcn_mfma_f32_32x32x16_bf16(pa2,PK(2),o[d0],0,0,0);
    o[d0]=__builtin_amdgcn_mfma_f32_32x32x16_bf16(pa3,PK(3),o[d0],0,0,0);
    #undef PK
  }
}
struct AttnUnit { int qcol,kcol,vcol,ocol,c,b,qb,T0; bf16* O; };
template<int VD> __device__ __forceinline__ void build_bias(char*shm,const float*BT,int c){
  float*tb=(float*)(shm+Lay<VD>::LDS_TB); const float*bt=BT+c*4096;
  for(int e=threadIdx.x;e<4*TB_NI;e+=NW*64){ const int s=e/TB_NI,i=e-s*TB_NI,d=DTOP-i-s; tb[s*(TB_STRIDE/4)+i]=d>=0?bt[d]:0.f; }
}
template<int N> __device__ __forceinline__ void wait_bar(){ asm volatile("s_waitcnt vmcnt(%0) lgkmcnt(0)\n\ts_barrier"::"n"(N):"memory"); }
template<int VD,int THRL> __device__ __forceinline__ void attn_unit(const AttnUnit&u,const bf16*QKV,char*shm,unsigned*qhead,unsigned&ticket){
  using L=Lay<VD>; constexpr int ND=VD/32, VM=VD/64;
  #define WB(kc,vc) wait_bar<(kc)+(vc)*VM>()
  int tid_=threadIdx.x; asm volatile("":"+v"(tid_));
  const int tid=tid_,lane=tid&63,r32=lane&31,hi=lane>>5; const int wid=__builtin_amdgcn_readfirstlane(tid>>6);
  const long rowbase=(long)u.b*SEQ; const int q0=u.qb*QB;
  const bf16*Qw=QKV+(rowbase+q0+wid*QBLK)*PQ+u.qcol;
  const bf16*Kh=QKV+(rowbase+(long)u.T0*KVBLK)*PQ+u.kcol,*Vh=QKV+(rowbase+(long)u.T0*KVBLK)*PQ+u.vcol;
  const unsigned lds0=(unsigned)(uintptr_t)shm;
  float*wsf=(float*)(shm+L::LDS_WS)+wid*64;
  const bf16*ksrc=Kh+(long)lane*PQ+wid*8;
  const bf16*vsrc=Vh+(long)(16*(wid&3)+(lane>>2))*PQ+(wid>>2)*32+(lane&3)*8;
  const unsigned kdst=lds0+L::LDS_K+wid*1024, vdst=lds0+L::LDS_V+wid*1024;
  #define DMA_K(t,slot) glds16(ksrc+(long)(t)*KVBLK*PQ,(unsigned)__builtin_amdgcn_readfirstlane(kdst+(slot)))
  #define DMA_V(t,slot) do{ _Pragma("unroll") for(int i_=0;i_<VM;++i_) glds16(vsrc+(long)(t)*KVBLK*PQ+64*i_,(unsigned)__builtin_amdgcn_readfirstlane(vdst+(slot)*VM+8192*i_)); }while(0)
  const int vb0=(int)(lds0+L::LDS_V)+((lane>>4)&1)*32+(lane&3)*8+(4*hi+((lane&15)>>2))*64;
  bf16x8 kf[8];
  const lds_cptr shm3=(lds_cptr)shm; const lds_cptr kp0=shm3+L::LDS_K+hi*1024+r32*16; const lds_cptr vp0=shm3+L::LDS_V+((lane>>4)&1)*32+(lane&3)*8+(4*hi+((lane&15)>>2))*64;
  const int NT=(q0+QB)/KVBLK-u.T0;
  const int sft=(4-(r32&3))&3; const lds_cptr tbs=shm3+L::LDS_TB+sft*TB_STRIDE;
  int bnext=DTOP-(q0+wid*QBLK+r32)+KVBLK*u.T0+4*hi-sft;
  #define BPTR() (tbs+4*(bnext>0?bnext:0))
  DMA_K(0,0);DMA_V(0,0);DMA_K(1,SLOTB);
  bf16x8 qr[4];
  #pragma unroll
  for(int d0=0;d0<4;++d0)qr[d0]=*reinterpret_cast<const bf16x8*>(&Qw[(long)r32*PQ+d0*16+hi*8]);
  const lds_cptr qlp=shm3+L::LDS_OST+wid*4096+lane*16; bf16x8 qx=qr[0],qy=qr[1];
  if constexpr(VD==128){
    #pragma unroll
    for(int d0=0;d0<4;++d0)*(__attribute__((address_space(3))) bf16x8*)(shm3+L::LDS_OST+wid*4096+lane*16+d0*1024)=qr[d0]; }
  #define QF(d0) (VD==128?(((d0)&1)?qy:qx):qr[d0])
  #define QLD(d0) do{ if constexpr(VD==128){ (((d0)&1)?qy:qx)=*(const __attribute__((address_space(3))) bf16x8*)(qlp+(d0)*1024); SBAR(); } }while(0)
  float mhat=0.f,l_reg=0.f;f32x16 o[ND];
  #pragma unroll
  for(int d_=0;d_<ND;++d_)o[d_]=f32x16{};
  const int qrel=wid*QBLK+r32;
  #define CMASK(P0,P1,t) do{int jb_=(t)-(NT-4); if(jb_>=0)cmask(P0,P1,jb_,qrel,hi);}while(0)
  bool resc=false;
  #define RESC() do{ if(resc){ asm volatile("s_waitcnt lgkmcnt(0)":::"memory"); \
      _Pragma("unroll") for(int d_=0;d_<ND;++d_) _Pragma("unroll") for(int r=0;r<16;++r)o[d_][r]*=wsf[crow(r,hi)]; } }while(0)
  f32x16 pA0,pA1,pB0,pB1;
  int sl_prev=0,sl_cur=0,sl_next=SLOTB;
  #define ROT() do{sl_prev=sl_cur;sl_cur=sl_next;sl_next=(sl_next==(NSLOT-1)*SLOTB)?0:sl_next+SLOTB;}while(0)
  DMA_K(2,2*SLOTB);
  WB(2,1);
  bload16(pA0,pA1,BPTR()); bnext+=KVBLK;
  { const char*kb=shm+L::LDS_K+hi*1024+r32*16;
    #pragma unroll
    for(int d0=0;d0<4;++d0){ const bf16x8 b0=*reinterpret_cast<const bf16x8*>(kb+d0*2048); const bf16x8 b1=*reinterpret_cast<const bf16x8*>(kb+d0*2048+512);
      pA0=__builtin_amdgcn_mfma_f32_32x32x16_bf16(b0,qr[d0],pA0,0,0,0); pA1=__builtin_amdgcn_mfma_f32_32x32x16_bf16(b1,qr[d0],pA1,0,0,0);} }
  asm volatile("s_nop 15\n\ts_nop 7":"+v"(pA0),"+v"(pA1));CMASK(pA0,pA1,0);
  { const float rm=rowmax(pA0,pA1); mhat=__builtin_fmaxf(rm,-1e30f);
    _Pragma("unroll") for(int r=0;r<16;++r){pA0[r]=__builtin_amdgcn_exp2f(fsub_s(pA0[r],mhat));}
    _Pragma("unroll") for(int r=0;r<16;++r){pA1[r]=__builtin_amdgcn_exp2f(fsub_s(pA1[r],mhat));} }
  WB(0,0);
  DMA_K(3,0);DMA_V(1,SLOTB);
  ROT();
  kload8(kf,kp0+sl_cur);
  bload16(pB0,pB1,BPTR()); bnext+=KVBLK;
  WB(1,1);
  s16x4 vlo[8],vhi[8]; u32x4 pw0,pw1,pw2,pw3;
  #define PKW(P,B) cvtpk_s(P[B],P[B+1])
  #define PAF(k) __builtin_bit_cast(bf16x8,pw##k)
  #define VFR(i) (bf16x8){vlo[i][0],vlo[i][1],vlo[i][2],vlo[i][3],vhi[i][0],vhi[i][1],vhi[i][2],vhi[i][3]}
  #define PIN(x) asm volatile("":"+v"(x))
  #define GAPA(MF,A0,A1,A2,A3,W0,W1,PW) do{ MF; sacc+=A0; sacc+=A1; sacc+=A2; sacc+=A3; PIN(sacc); W0; W1; PIN(PW); SBAR(); }while(0)
  #define EX(v) __builtin_amdgcn_exp2f(fsub_s(v,mhat))
  #define GAPB(MF,X,B) do{ MF; X[B]=EX(X[B]); X[B+1]=EX(X[B+1]); X[B+2]=EX(X[B+2]); X[B+3]=EX(X[B+3]); PIN(X); SBAR(); }while(0)
  #define GAPB2(MF,X,B) do{ MF; X[B]=EX(X[B]); X[B+1]=EX(X[B+1]); PIN(X); SBAR(); }while(0)
  #define VRDF(sl,d0,ks) do{ vlo[sl]=vtr(vp_+((d0)*4096+(ks)*1024)); vhi[sl]=vtr(vp_+((d0)*4096+(ks)*1024+512)); }while(0)
  #define KRD(G,j) do{ if(G){ kload2(kf,kp0+sl_next,j); SBAR(); } }while(0)
  #define BRD(G,P,off,g) do{ if(G){ bload2(P,bp_,off,g); bload2(P,bp_,off,(g)+1); SBAR(); } }while(0)
  #define MF32(a,b,c) __builtin_amdgcn_mfma_f32_32x32x16_bf16(a,b,c,0,0,0)
  #define VA64(j) VRDF(((j)>>1)+4*((j)&1),(j)&1,(j)>>1)
  #define VA128(j) VRDF(j,(j)&3,(j)>>2)
  #define PHASE_A(C0,C1,P0,P1,VA) \
    VA(0); SBAR(); float sacc=(P0[0]+P0[1]); \
    QLD(1); GAPA(C0=MF32(kf[0],QF(0),C0), P0[2],P0[3],P0[4],P0[5],     pw0[0]=PKW(P0,0), pw0[1]=PKW(P0,2), pw0); \
    VA(1); SBAR(); GAPA(C1=MF32(kf[1],QF(0),C1), P0[6],P0[7],P0[8],P0[9],     pw0[2]=PKW(P0,4), pw0[3]=PKW(P0,6), pw0); \
    VA(2); SBAR(); QLD(2); GAPA(C0=MF32(kf[2],QF(1),C0), P0[10],P0[11],P0[12],P0[13], pw1[0]=PKW(P0,8), pw1[1]=PKW(P0,10), pw1); \
    VA(3); SBAR(); GAPA(C1=MF32(kf[3],QF(1),C1), P0[14],P0[15],P1[0],P1[1],   pw1[2]=PKW(P0,12),pw1[3]=PKW(P0,14), pw1); \
    VA(4); SBAR(); QLD(3); GAPA(C0=MF32(kf[4],QF(2),C0), P1[2],P1[3],P1[4],P1[5],     pw2[0]=PKW(P1,0), pw2[1]=PKW(P1,2), pw2); \
    VA(5); SBAR(); GAPA(C1=MF32(kf[5],QF(2),C1), P1[6],P1[7],P1[8],P1[9],     pw2[2]=PKW(P1,4), pw2[3]=PKW(P1,6), pw2); \
    VA(6); SBAR(); GAPA(C0=MF32(kf[6],QF(3),C0), P1[10],P1[11],P1[12],P1[13], pw3[0]=PKW(P1,8), pw3[1]=PKW(P1,10), pw3); \
    VA(7); SBAR(); GAPA(C1=MF32(kf[7],QF(3),C1), P1[14],P1[15],0.f,0.f,       pw3[2]=PKW(P1,12),pw3[3]=PKW(P1,14), pw3); \
    l_reg+=sacc;
  #define DECIDE(C0,C1,t,GK,GV) \
    if(GK){DMA_K((t)+3,sl_cur);} if(GV){DMA_V((t)+1,sl_next);} \
    CMASK(C0,C1,t); \
    { float a=MX3(C0[0],C0[1],C1[0]),b=MX3(C0[2],C0[3],C1[1]); a=MX3(a,C1[2],C1[3]); \
      _Pragma("unroll") for(int r=4;r<16;r+=4){a=MX3(a,C0[r],C0[r+1]);b=MX3(b,C0[r+2],C0[r+3]);a=MX3(a,C1[r],C1[r+1]);b=MX3(b,C1[r+2],C1[r+3]);} \
      float rm=__builtin_fmaxf(a,b); { auto rr=__builtin_amdgcn_permlane32_swap(__float_as_uint(rm),__float_as_uint(rm),false,false); rm=__builtin_fmaxf(__uint_as_float(rr[0]),__uint_as_float(rr[1])); } \
      resc=false; \
      if(__builtin_expect(__any(rm-mhat>(float)THRL),0)){ const float mn=__builtin_fmaxf(rm,mhat); const float f=__builtin_amdgcn_exp2f(mhat-mn); mhat=mn; \
        l_reg*=f; if(hi==0)wsf[r32]=f; resc=true; } } \
    SBAR();
  #define STEP(C0,C1,P0,P1,t,GK,GV,GL) do{ SBAR(); \
    const lds_cptr vp_=vp0+sl_prev*VM; const lds_cptr bp_=BPTR(); \
    if constexpr(VD==64){ \
      PHASE_A(C0,C1,P0,P1,VA64) \
      DECIDE(C0,C1,t,GK,GV) \
      GAPB(o[0]=MF32(PAF(0),VFR(0),o[0]), C0,0); \
      BRD(GL,P0,0,0); GAPB(o[1]=MF32(PAF(0),VFR(4),o[1]), C0,4); \
      KRD(GL,0); GAPB(o[0]=MF32(PAF(1),VFR(1),o[0]), C0,8); \
      KRD(GL,1); GAPB(o[1]=MF32(PAF(1),VFR(5),o[1]), C0,12); \
      KRD(GL,2); GAPB(o[0]=MF32(PAF(2),VFR(2),o[0]), C1,0); \
      KRD(GL,3); GAPB(o[1]=MF32(PAF(2),VFR(6),o[1]), C1,4); \
      BRD(GL,P0,0,2); GAPB(o[0]=MF32(PAF(3),VFR(3),o[0]), C1,8); \
      BRD(GL,P1,128,0); GAPB(o[1]=MF32(PAF(3),VFR(7),o[1]), C1,12); \
      BRD(GL,P1,128,2); \
    } else { \
      PHASE_A(C0,C1,P0,P1,VA128) \
      DECIDE(C0,C1,t,GK,GV) \
        \
      GAPB2(o[0]=MF32(PAF(0),VFR(0),o[0]), C0,0);  VRDF(0,0,2); SBAR(); \
      GAPB2(o[1]=MF32(PAF(0),VFR(1),o[1]), C0,2);  VRDF(1,1,2); SBAR(); \
      GAPB2(o[2]=MF32(PAF(0),VFR(2),o[2]), C0,4);  VRDF(2,2,2); SBAR(); \
      GAPB2(o[3]=MF32(PAF(0),VFR(3),o[3]), C0,6);  VRDF(3,3,2); SBAR(); \
      KRD(GL,0); GAPB2(o[0]=MF32(PAF(1),VFR(4),o[0]), C0,8);  VRDF(4,0,3); SBAR(); \
      KRD(GL,1); GAPB2(o[1]=MF32(PAF(1),VFR(5),o[1]), C0,10); VRDF(5,1,3); SBAR(); \
      KRD(GL,2); GAPB2(o[2]=MF32(PAF(1),VFR(6),o[2]), C0,12); VRDF(6,2,3); SBAR(); \
      KRD(GL,3); GAPB2(o[3]=MF32(PAF(1),VFR(7),o[3]), C0,14); VRDF(7,3,3); SBAR(); \
      BRD(GL,P0,0,0); GAPB2(o[0]=MF32(PAF(2),VFR(0),o[0]), C1,0); \
      BRD(GL,P0,0,2); GAPB2(o[1]=MF32(PAF(2),VFR(1),o[1]), C1,2); \
      BRD(GL,P1,128,0); GAPB2(o[2]=MF32(PAF(2),VFR(2),o[2]), C1,4); \
      BRD(GL,P1,128,2); GAPB2(o[3]=MF32(PAF(2),VFR(3),o[3]), C1,6); \
      GAPB2(o[0]=MF32(PAF(3),VFR(4),o[0]), C1,8); \
      GAPB2(o[1]=MF32(PAF(3),VFR(5),o[1]), C1,10); \
      GAPB2(o[2]=MF32(PAF(3),VFR(6),o[2]), C1,12); \
      QLD(0); GAPB2(o[3]=MF32(PAF(3),VFR(7),o[3]), C1,14); \
    } \
    bnext+=KVBLK; \
    }while(0)
  int t=1;
  #undef CMASK
  #define CMASK(P0,P1,t) do{}while(0)
  for(;t+5<NT;t+=2){
    STEP(pB0,pB1,pA0,pA1,t,true,true,true);     WB(1,1); RESC(); ROT();
    STEP(pA0,pA1,pB0,pB1,t+1,true,true,true);   WB(1,1); RESC(); ROT();
  }
  #undef CMASK
  #define CMASK(P0,P1,t) do{int jb_=(t)-(NT-4); if(jb_>=0)cmask(P0,P1,jb_,qrel,hi);}while(0)
  #define ENDW(tt) do{ if((tt)+3<NT){WB(1,1);} else if((tt)+2<NT){WB(0,1);} else {WB(0,0);} }while(0)
  for(;t+1<NT;t+=2){
    STEP(pB0,pB1,pA0,pA1,t,(t+3<NT),(t+1<NT),(t+1<NT));       ENDW(t);   RESC(); ROT();
    STEP(pA0,pA1,pB0,pB1,t+1,(t+4<NT),(t+2<NT),(t+2<NT));     ENDW(t+1); RESC(); ROT();
  }
  STEP(pB0,pB1,pA0,pA1,NT-1,false,false,false); RESC();
  if(tid==0)ticket=__hip_atomic_fetch_add(qhead,1u,__ATOMIC_RELAXED,__HIP_MEMORY_SCOPE_AGENT);
  { float sacc=pB0[0]+pB0[1]; _Pragma("unroll") for(int r=2;r<16;++r)sacc+=pB0[r]; _Pragma("unroll") for(int r=0;r<16;++r)sacc+=pB1[r]; l_reg+=sacc;
    pw0=(u32x4){PKW(pB0,0),PKW(pB0,2),PKW(pB0,4),PKW(pB0,6)};pw1=(u32x4){PKW(pB0,8),PKW(pB0,10),PKW(pB0,12),PKW(pB0,14)};pw2=(u32x4){PKW(pB1,0),PKW(pB1,2),PKW(pB1,4),PKW(pB1,6)};pw3=(u32x4){PKW(pB1,8),PKW(pB1,10),PKW(pB1,12),PKW(pB1,14)};
    SBAR(); pv<ND>(o,vb0+sl_cur*VM,PAF(0),PAF(1),PAF(2),PAF(3)); }
  {auto rr=__builtin_amdgcn_permlane32_swap(__float_as_uint(l_reg),__float_as_uint(l_reg),false,false);l_reg=__uint_as_float(rr[0])+__uint_as_float(rr[1]);}
  if(hi==0)wsf[32+r32]=l_reg;asm volatile("s_waitcnt lgkmcnt(0)":::"memory");
  float rli[16];
  #pragma unroll
  for(int r=0;r<16;++r)rli[r]=__builtin_amdgcn_rcpf(wsf[32+crow(r,hi)]);
  bf16*Ow=u.O+(rowbase+q0+wid*QBLK)*PO+u.ocol; const __amdgpu_buffer_rsrc_t orsrc=__builtin_amdgcn_make_buffer_rsrc((void*)Ow,0,QBLK*PO*2,0x00020000);
  { bf16*stg=(bf16*)(shm+L::LDS_OST)+wid*2048;
    #pragma unroll
    for(int p=0;p<VM;++p){
      #pragma unroll
      for(int r=0;r<16;++r){const int orow=crow(r,hi);
        #pragma unroll
        for(int d0=0;d0<2;++d0)stg[orow*64+d0*32+r32]=__float2bfloat16(o[2*p+d0][r]*rli[r]);}
      asm volatile("s_waitcnt lgkmcnt(0)":::"memory");
      #pragma unroll
      for(int i=0;i<4;++i){const int row=i*8+(lane>>3),ch=lane&7; const u32x4 v=*(const u32x4*)(stg+row*64+ch*8); __builtin_amdgcn_raw_buffer_store_b128(v,orsrc,(unsigned)((row*PO+p*64+ch*8)*2),0,16);}
      asm volatile("s_waitcnt lgkmcnt(0)":::"memory"); } }
  asm volatile("s_waitcnt lgkmcnt(0)\n\ts_barrier":::"memory");
  #undef PKW
  #undef PAF
  #undef VFR
  #undef PIN
  #undef GAPA
  #undef GAPB
  #undef GAPB2
  #undef EX
  #undef VRDF
  #undef KRD
  #undef BRD
  #undef MF32
  #undef PHASE_A
  #undef QF
  #undef QLD
  #undef VA64
  #undef VA128
  #undef DECIDE
  #undef STEP
  #undef ENDW
  #undef DMA_K
  #undef DMA_V
  #undef CMASK
  #undef RESC
  #undef ROT
  #undef BPTR
  #undef WB
}
constexpr int ATTN_LDS_BYTES=Lay<128>::LDS_BYTES;
#undef SBAR
#undef WAIT_BAR
#undef MX3
}
#define GAS __attribute__((address_space(1)))
#define LAS __attribute__((address_space(3)))
typedef unsigned short bf16;
typedef unsigned v4u __attribute__((ext_vector_type(4)));
typedef float f32x4 __attribute__((ext_vector_type(4)));
typedef short bf16x8 __attribute__((ext_vector_type(8)));
typedef GAS unsigned gu32;
typedef GAS unsigned long long gu64;
#define RLX_AGENT __ATOMIC_RELAXED, __HIP_MEMORY_SCOPE_AGENT
#define LDS_WAIT() asm volatile("s_waitcnt lgkmcnt(0)" ::: "memory")
#define VM_WAIT() asm volatile("s_waitcnt vmcnt(0)" ::: "memory")
__device__ __forceinline__ unsigned long long rt() { return __builtin_amdgcn_s_memrealtime(); }

#define XB_TMO      128
#define XB_XCNT(j)  (256  + 64 * (j))
#define XB_XSUB(j)  (1280 + 64 * (j))
#define XB_XGEN(j)  (2304 + 64 * (j))
#define XB_TOP      3328
#define XB_TOPGEN   3392
#define XCD_BAR_WORDS 3456
#define XB_SPIN_CAP (1u << 18)

__device__ __forceinline__ unsigned xb_ld(unsigned* p)              { return __hip_atomic_load(p, __ATOMIC_RELAXED, __HIP_MEMORY_SCOPE_AGENT); }
__device__ __forceinline__ unsigned xb_add(unsigned* p, unsigned v) { return __hip_atomic_fetch_add(p, v, __ATOMIC_RELAXED, __HIP_MEMORY_SCOPE_AGENT); }
__device__ __forceinline__ unsigned xb_xcc_id() { return (unsigned)__builtin_amdgcn_s_getreg((3 << 11) | 20) & 0xFu; }
#define XB_SPIN(cond, bar) do { unsigned _sp = 0; while (cond) { __builtin_amdgcn_s_sleep(1); \
    if ((++_sp & 255u) == 0u) { if (xb_ld(&(bar)[XB_TMO])) break; if (_sp > XB_SPIN_CAP) { atomicAdd(&(bar)[XB_TMO], 1u); break; } } } } while (0)

struct XcdBarrier {
    unsigned* bar; unsigned x;
    volatile LAS unsigned* st;
};

__device__ __forceinline__ XcdBarrier xcd_barrier_post(unsigned* bar, volatile LAS unsigned* st) {
    XcdBarrier b; b.bar = bar; b.x = xb_xcc_id(); b.st = st;
    if (threadIdx.x == 0) (void)xb_add(&bar[XB_XCNT(b.x)], 1u);
    return b;
}
__device__ __forceinline__ void xcd_barrier_complete(unsigned* bar, unsigned x, unsigned& nloc, unsigned& nx) {
    const unsigned G = gridDim.x * gridDim.y * gridDim.z;
    unsigned sum, cnt, mine, sp = 0u;
    for (;;) {
        sum = 0u; cnt = 0u; mine = 0u;
#pragma unroll
        for (unsigned j = 0; j < 16; ++j) { const unsigned c = xb_ld(&bar[XB_XCNT(j)]); sum += c; cnt += (c > 0u) ? 1u : 0u; mine = (j == x) ? c : mine; }
        if (sum == G) break;
        __builtin_amdgcn_s_sleep(1);
        if ((++sp & 255u) == 0u) { if (xb_ld(&bar[XB_TMO])) break; if (sp > XB_SPIN_CAP) { atomicAdd(&bar[XB_TMO], 1u); break; } }
    }
    nloc = mine > 0u ? mine : 1u; nx = cnt > 0u ? cnt : 1u;
}

__device__ __forceinline__ void xcd_barrier(const XcdBarrier& b) {
    asm volatile("s_waitcnt vmcnt(0)" ::: "memory");
    __syncthreads();
    if (threadIdx.x == 0) {
        unsigned* bar = b.bar;
        __builtin_amdgcn_s_waitcnt(0);
        unsigned nloc = b.st[0], nx = b.st[1];
        if (nloc == 0u) { xcd_barrier_complete(bar, b.x, nloc, nx); b.st[0] = nloc; b.st[1] = nx; }
        const unsigned old = xb_add(&bar[XB_XSUB(b.x)], 1u);
        const unsigned gen = old / nloc;
        if (old + 1u == (gen + 1u) * nloc) {
            __builtin_amdgcn_fence(__ATOMIC_RELEASE, "agent");
            asm volatile("s_waitcnt vmcnt(0)" ::: "memory");
            const unsigned og = xb_add(&bar[XB_TOP], 1u);
            const unsigned tg = og / nx;
            if (og + 1u == (tg + 1u) * nx) xb_add(&bar[XB_TOPGEN], 1u);
            else XB_SPIN(xb_ld(&bar[XB_TOPGEN]) == tg, bar);
            __builtin_amdgcn_fence(__ATOMIC_ACQUIRE, "agent");
            xb_add(&bar[XB_XGEN(b.x)], 1u);
            asm volatile("s_waitcnt vmcnt(0)" ::: "memory");
        } else {
            XB_SPIN(xb_ld(&bar[XB_XGEN(b.x)]) == gen, bar);
            __builtin_amdgcn_fence(__ATOMIC_ACQUIRE, "agent");
            asm volatile("s_waitcnt vmcnt(0)" ::: "memory");
        }
    }
    __syncthreads();
}
__device__ __forceinline__ int t5_bucket(int d) {
    if (d < 16) return d < 0 ? 0 : d;
    int b = 16;
    b += (d >= 22); b += (d >= 30); b += (d >= 40); b += (d >= 54); b += (d >= 73); b += (d >= 99); b += (d >= 134); b += (d >= 182);
    b += (d >= 246); b += (d >= 332); b += (d >= 450); b += (d >= 609); b += (d >= 825); b += (d >= 1117); b += (d >= 1513);
    return b;
}
__device__ __forceinline__ void p0_transpose_item(const float* W, const float* g, int K, int N, bf16* WT, int kind, LAS float* scr, int item, int lane) {
    const int nblk = N / 64, kb = item / nblk, nb = item % nblk, k0 = 64 * kb, n0 = 64 * nb;
    float sc = 1.f; if (kind == 3 && ((n0 >= COL_QA && n0 < COL_KA) || (n0 >= COL_QB && n0 < COL_KB))) sc = C2;
    const int lk = lane >> 4, ln = (lane & 15) * 4;
    f32x4 v[16];
#pragma unroll
    for (int i = 0; i < 16; ++i) v[i] = *(const GAS f32x4*)(W + (size_t)(k0 + 4 * i + lk) * N + n0 + ln);
#pragma unroll
    for (int i = 0; i < 16; ++i) { const int kk = 4 * i + lk; const float gk = g ? g[k0 + kk] * sc : sc; LAS float* d = scr + kk * 65 + ln; d[0] = v[i].x * gk; d[1] = v[i].y * gk; d[2] = v[i].z * gk; d[3] = v[i].w * gk; }
    LDS_WAIT(); asm volatile("" ::: "memory");
    int r0 = n0; if (kind == 1) r0 = (n0 / 128) * 256 + (n0 % 128); else if (kind == 2) r0 = (n0 / 128) * 256 + 128 + (n0 % 128);
    const int c = lane & 7;
#pragma unroll
    for (int j = 0; j < 8; ++j) { const int n = (lane >> 3) + 8 * j; const LAS float* s = scr + (8 * c) * 65 + n;
        v4u o; o.x = pk2(s[0 * 65], s[1 * 65]); o.y = pk2(s[2 * 65], s[3 * 65]); o.z = pk2(s[4 * 65], s[5 * 65]); o.w = pk2(s[6 * 65], s[7 * 65]);
        *(GAS v4u*)(WT + (size_t)(r0 + n) * K + k0 + 8 * c) = o; }
    LDS_WAIT(); asm volatile("" ::: "memory");
}

struct Args { const float* in[19]; float* out; unsigned char* ws; int ph_lo, ph_hi; };
constexpr int PH_PRO = 0, PH_L0 = 1, PH_PER_LAYER = 8, PH_FINAL = PH_L0 + DEPTH * PH_PER_LAYER, N_PHASES = PH_FINAL + 1;

__device__ __forceinline__ void attn_naive_item(const bf16* QKV, const float* BT, bf16* OD, bf16* MIX, LAS float* sc, LAS float* qs, int job, int t, int lane) {
    const bool dil = job >= 32; int b, qcol, kcol, vcol, ocol, c; bf16* O;
    if (!dil) { const int m = job & 1, h = (job >> 1) & 3; b = job >> 3; qcol = COL_QA + h * 128 + m * 64; kcol = COL_KA + h * 128 + m * 64; vcol = COL_VA + h * 128; ocol = m * 512 + h * 128; c = h * 2 + m; O = OD; }
    else { const int j = job - 32, h = j & 7; b = j >> 3; qcol = COL_QB + h * 64; kcol = COL_KB + h * 64; vcol = COL_VB + h * 64; ocol = 512 + h * 64; c = 8 + h; O = MIX; }
    const size_t rb = (size_t)b * SEQ;
    qs[lane] = bf2f(QKV[(rb + t) * NQKV + qcol + lane]);
    LDS_WAIT(); asm volatile("" ::: "memory");
    const int lo = dil ? (t > 2048 ? t - 2048 : 0) : 0, n = t - lo + 1;
    const float* bt = BT + c * 4096;
    float mx = -INFINITY;
    for (int kk = lane; kk < n; kk += 64) { const int k = lo + kk; const v4u* kr = (const v4u*)(QKV + (rb + k) * NQKV + kcol); float s = 0.f;
#pragma unroll
        for (int j = 0; j < 8; ++j) { const v4u u = kr[j]; const LAS float* q = qs + j * 8;
            s += q[0] * bf2f(u.x & 0xffff) + q[1] * bf2f(u.x >> 16) + q[2] * bf2f(u.y & 0xffff) + q[3] * bf2f(u.y >> 16) + q[4] * bf2f(u.z & 0xffff) + q[5] * bf2f(u.z >> 16) + q[6] * bf2f(u.w & 0xffff) + q[7] * bf2f(u.w >> 16); }
        s += bt[t - k]; sc[kk] = s; mx = fmaxf(mx, s); }
    mx = wave_max(mx); float l = 0.f;
    for (int kk = lane; kk < n; kk += 64) { const float p = exp2f(sc[kk] - mx); sc[kk] = p; l += p; }
    l = wave_sum(l);
    LDS_WAIT(); asm volatile("" ::: "memory");
    const float il = 1.f / l;
    if (!dil) { float o0 = 0.f, o1 = 0.f;
        for (int kk = 0; kk < n; ++kk) { const float p = sc[kk]; const unsigned u = *(const unsigned*)(QKV + (rb + lo + kk) * NQKV + vcol + 2 * lane); o0 += p * bf2f(u & 0xffff); o1 += p * bf2f(u >> 16); }
        *(unsigned*)(O + (rb + t) * DM + ocol + 2 * lane) = pk2(o0 * il, o1 * il);
    } else { float o0 = 0.f;
        for (int kk = 0; kk < n; ++kk) { const float p = sc[kk]; o0 += p * bf2f(QKV[(rb + lo + kk) * NQKV + vcol + lane]); }
        O[(rb + t) * DM + ocol + lane] = (bf16)f2bf(o0 * il); }
    LDS_WAIT(); asm volatile("" ::: "memory");
}

struct QTab { unsigned char v[128]; };
constexpr QTab make_qtab() { QTab t{}; int cost[128] = {};
    for (int i = 0; i < 128; ++i) { const int kind = i >> 6, qb = i & 15; t.v[i] = (unsigned char)i; const int st = 4 * (qb + 1); cost[i] = kind == 0 ? st * 13 : (st < 36 ? st : 36) * 10; }
    for (int i = 0; i < 128; ++i) { int b = i; for (int j = i + 1; j < 128; ++j) if (cost[j] > cost[b]) b = j; const int c = cost[i]; cost[i] = cost[b]; cost[b] = c; const unsigned char v = t.v[i]; t.v[i] = t.v[b]; t.v[b] = v; }
    return t; }
__constant__ QTab QTAB = make_qtab();
#ifndef REP_GU
#define REP_GU 1
#endif
#ifndef REP_DN
#define REP_DN 1
#endif
#ifndef REP_QKV
#define REP_QKV 1
#endif
#ifndef REP_ATTN
#define REP_ATTN 1
#endif
#ifndef REP_COMB
#define REP_COMB 1
#endif
#ifndef REP_WOUT
#define REP_WOUT 1
#endif
#ifndef REP_PRO
#define REP_PRO 1
#endif
#ifndef MK_NAIVE_ATTN
#define MK_NAIVE_ATTN 0
#endif
__global__ void __launch_bounds__(NWAVES * 64, 2) mk_fwd(Args args) {
    extern __shared__ __attribute__((aligned(16))) unsigned char lds_raw[];
    LAS unsigned char* lds = (LAS unsigned char*)lds_raw;
    volatile LAS unsigned* MISC = (volatile LAS unsigned*)(lds + MISC_OFF);
    const int tid = threadIdx.x, lane = tid & 63, wave = __builtin_amdgcn_readfirstlane(tid >> 6);
    const int G = gridDim.x; const int bx = blockIdx.x; const int vcu = (G % 8 == 0) ? (bx % 8) * (G / 8) + bx / 8 : bx;
    unsigned char* ws = args.ws;
    gu32* ctl = (gu32*)(ws + WS_CTL);
    float* X = args.out; float* BT = (float*)(ws + WS_BT); float* LAM = (float*)(ws + WS_LAM); float* SS = (float*)(ws + WS_SS);
    bf16* W = (bf16*)(ws + WS_W); bf16* XB = (bf16*)(ws + WS_XB); bf16* OD = (bf16*)(ws + WS_OD); bf16* HQ = (bf16*)(ws + WS_HQKV); bf16* MIX = (bf16*)(ws + WS_MIX);
    for (int u = tid; u < (LDS_BYTES - LDSCTL_OFF) / 4; u += NWAVES * 64) ((LAS unsigned*)(lds + LDSCTL_OFF))[u] = 0u;
    __syncthreads();
    const int lo = args.ph_lo, hi = args.ph_hi;
    const bool multi = (hi - lo) > 1;
    XcdBarrier bar; bar.bar = (unsigned*)(ctl + CW_BAR); bar.x = 0; bar.st = nullptr;
    if (multi) bar = xcd_barrier_post((unsigned*)(ctl + CW_BAR), MISC + 8);
#define IN(k) (lo <= (k) && (k) < hi)
#define FRESH_LANE(name) int name = threadIdx.x; asm volatile("" : "+v"(name)); name &= 63
#define SEAM(k) do { if (IN((k) + 1)) xcd_barrier(bar); } while (0)
    const int gw = vcu * NWAVES + wave, NGW = G * NWAVES;

    if (IN(PH_PRO)) {
        for (int i = gw * 64 + lane; i < 16 * 4096; i += NGW * 64) { const int c = i >> 12, d = i & 4095;
            float v = LOG2E * args.in[17][t5_bucket(d) * 16 + c];
            if (c >= 8) { const int mult = (d <= 128 ? 1 : 0) + ((d % 4 == 0 && d <= 512) ? 1 : 0) + ((d % 16 == 0 && d <= 2048) ? 1 : 0); v = mult == 0 ? -INFINITY : v + __builtin_log2f((float)mult); }
            BT[i] = v; }
        if (gw < DEPTH) { const int l = gw; const float a = wave_sum(args.in[7][l * 64 + lane] * args.in[8][l * 64 + lane]), b = wave_sum(args.in[9][l * 64 + lane] * args.in[10][l * 64 + lane]);
            const float lam0 = 0.8f - 0.6f * __expf(-0.3f * (float)l); if (lane == 0) { LAM[l * 2 + 0] = __expf(a) - __expf(b) + lam0; LAM[l * 2 + 1] = 1.0f - lam0; } }
        _Pragma("unroll 1") for (int rep = 0; rep < REP_PRO; ++rep) {
        LAS float* scr = (LAS float*)(lds + RING_OFF + wave * 16640);
        constexpr int I_G = (DM / 64) * (DFF / 64), I_D = (DFF / 64) * (DM / 64), I_IN = (DM / 64) * (NQKV / 64), I_OUT = (DM / 64) * (DM / 64);
        constexpr int I_LAYER = 4 * I_G + 2 * I_D + I_IN + I_OUT;
        for (int it = gw; it < DEPTH * I_LAYER; it += NGW) {
            const int l = it / I_LAYER; int r = it % I_LAYER; bf16* Wl = W + (size_t)l * W_LAYER;
            if (r < I_G) { p0_transpose_item(args.in[2] + (size_t)l * DM * DFF, args.in[1] + l * DM, DM, DFF, Wl + W_GU1, 1, scr, r, lane); continue; } r -= I_G;
            if (r < I_G) { p0_transpose_item(args.in[3] + (size_t)l * DM * DFF, args.in[1] + l * DM, DM, DFF, Wl + W_GU1, 2, scr, r, lane); continue; } r -= I_G;
            if (r < I_D) { p0_transpose_item(args.in[4] + (size_t)l * DFF * DM, nullptr, DFF, DM, Wl + W_D1, 0, scr, r, lane); continue; } r -= I_D;
            if (r < I_IN) { p0_transpose_item(args.in[6] + (size_t)l * DM * NQKV, args.in[5] + l * DM, DM, NQKV, Wl + W_IN, 3, scr, r, lane); continue; } r -= I_IN;
            if (r < I_OUT) { p0_transpose_item(args.in[12] + (size_t)l * DM * DM, nullptr, DM, DM, Wl + W_OUT, 0, scr, r, lane); continue; } r -= I_OUT;
            if (r < I_G) { p0_transpose_item(args.in[14] + (size_t)l * DM * DFF, args.in[13] + l * DM, DM, DFF, Wl + W_GU2, 1, scr, r, lane); continue; } r -= I_G;
            if (r < I_G) { p0_transpose_item(args.in[15] + (size_t)l * DM * DFF, args.in[13] + l * DM, DM, DFF, Wl + W_GU2, 2, scr, r, lane); continue; } r -= I_G;
            p0_transpose_item(args.in[16] + (size_t)l * DFF * DM, nullptr, DFF, DM, Wl + W_D2, 0, scr, r, lane);
        }
        for (int row = gw; row < M; row += NGW) { const GAS f32x4* xr = (const GAS f32x4*)(args.in[0] + (size_t)row * DM) + lane; float s = 0.f; f32x4 v[4];
#pragma unroll
            for (int j = 0; j < 4; ++j) v[j] = xr[64 * j];
#pragma unroll
            for (int j = 0; j < 4; ++j) { s += (v[j].x * v[j].x + v[j].y * v[j].y) + (v[j].z * v[j].z + v[j].w * v[j].w); v2u o; o.x = pk2(v[j].x, v[j].y); o.y = pk2(v[j].z, v[j].w); ((GAS v2u*)(XB + (size_t)row * DM) + lane)[64 * j] = o; }
            s = wave_sum(s); if (lane == 0) *(GAS f32x4*)(SS + (size_t)row * 4) = (f32x4){s, 0.f, 0.f, 0.f}; }
        }
        SEAM(PH_PRO);
    }

#pragma unroll 1
    for (int l = 0; l < DEPTH; ++l) {
        const int pb = PH_L0 + l * PH_PER_LAYER; bf16* Wl = W + (size_t)l * W_LAYER;
#pragma unroll 1
        for (int f = 0; f < 2; ++f) {
            const int pg = pb + (f ? 6 : 0);
            if (f == 1) {
                if (IN(pb + 2)) { _Pragma("unroll 1") for (int rep = 0; rep < REP_QKV; ++rep) { pg8::Gemm g{XB, Wl + W_IN, M, NQKV, DM}; pg8::StaticOrder S; S.init(M, NQKV, G, bx);
                    pg8::EpiQKV E{HQ, NQKV, SS}; pg8::gemm_phase<pg8::EpiQKV, pg8::StaticOrder, true, true>(lds + RING_OFF, g, S, E); } SEAM(pb + 2); }
                if (IN(pb + 3)) {
#if MK_NAIVE_ATTN
                    FRESH_LANE(lane_l);
                    LAS float* sc = (LAS float*)(lds + RING_OFF + wave * 16384); LAS float* qs = (LAS float*)(lds + QS_OFF + wave * 256);
                    for (int i = gw, k = 0; i < 64 * SEQ; i += NGW, ++k) { const int job = i / SEQ, tt = i % SEQ; const int t = (job & 1) ? (SEQ - 1 - tt) : tt;
                        attn_naive_item(HQ, BT, OD, MIX, sc, qs, job, t, lane_l); }
#else
                    int cur_c = -1; const int x0 = (int)(((long)vcu * 8) / G) & 7; gu32* qbase = ctl + CW_Q + l * 8 * 64;
                    _Pragma("unroll 1") for (int rep = 0; rep < REP_ATTN; ++rep)
                    for (int sq = 0; sq < 8; ++sq) { const int xq = (x0 + sq) & 7; gu32* qh = qbase + xq * 64 + rep * 16;
                        if (tid == 0) MISC[12] = __hip_atomic_fetch_add(qh, 1u, RLX_AGENT);
                        __syncthreads(); unsigned idx = (unsigned)__builtin_amdgcn_readfirstlane((int)MISC[12]); __syncthreads();
                        while (idx < 128u) {
                            unsigned nxt = 0u;
                            const unsigned code = QTAB.v[idx]; const int kind = code >> 6, hd = (code >> 4) & 3, qb = code & 15;
                            attn_body::AttnUnit u; u.qb = qb;
                            if (kind == 0) { const int e = 4 * xq + hd, mp = e & 1, h = (e >> 1) & 3; u.b = e >> 3; u.qcol = COL_QA + h * 128 + mp * 64; u.kcol = COL_KA + h * 128 + mp * 64; u.vcol = COL_VA + h * 128;
                                u.ocol = mp * 512 + h * 128; u.c = h * 2 + mp; u.T0 = 0; u.O = (attn_body::bf16*)OD;
                                if (u.c != cur_c) { attn_body::build_bias<128>((char*)lds_raw + RING_OFF, BT, u.c); cur_c = u.c; }
                                attn_body::attn_unit<128, 8>(u, (const attn_body::bf16*)HQ, (char*)lds_raw + RING_OFF, (unsigned*)qh, nxt); }
                            else { const int f = 4 * xq + hd, h = f & 7; u.b = f >> 3; u.qcol = COL_QB + h * 64; u.kcol = COL_KB + h * 64; u.vcol = COL_VB + h * 64; u.ocol = 512 + h * 64; u.c = 8 + h; u.T0 = qb > 8 ? 4 * qb - 32 : 0; u.O = (attn_body::bf16*)MIX;
                                if (u.c != cur_c) { attn_body::build_bias<64>((char*)lds_raw + RING_OFF, BT, u.c); cur_c = u.c; }
                                attn_body::attn_unit<64, 8>(u, (const attn_body::bf16*)HQ, (char*)lds_raw + RING_OFF, (unsigned*)qh, nxt); }
                            if (tid == 0) MISC[12] = nxt;
                            __syncthreads(); idx = (unsigned)__builtin_amdgcn_readfirstlane((int)MISC[12]); __syncthreads();
                        }
                    }
#endif
                    SEAM(pb + 3); }
                if (IN(pb + 4)) { FRESH_LANE(lane_l); const float lam = LAM[2 * l], oml = LAM[2 * l + 1]; const float* gain = args.in[11] + l * 128; const float g0 = gain[lane_l], g1 = gain[lane_l + 64];
                    _Pragma("unroll 1") for (int rep = 0; rep < REP_COMB; ++rep)
                    for (int item = gw; item < M * 4; item += NGW) { const int row = item >> 2, h = item & 3;
                        const bf16* o1 = OD + (size_t)row * DM + h * 128, *o2 = o1 + 512;
                        const float d0 = bf2f(o1[lane_l]) - lam * bf2f(o2[lane_l]), d1 = bf2f(o1[lane_l + 64]) - lam * bf2f(o2[lane_l + 64]);
                        const float r = __builtin_amdgcn_rsqf(wave_sum(d0 * d0 + d1 * d1) * (1.0f / 128.0f) + EPS) * oml;
                        MIX[(size_t)row * DM + h * 128 + lane_l] = (bf16)f2bf(d0 * r * g0); MIX[(size_t)row * DM + h * 128 + lane_l + 64] = (bf16)f2bf(d1 * r * g1); }
                    SEAM(pb + 4); }
                if (IN(pb + 5)) { _Pragma("unroll 1") for (int rep = 0; rep < REP_WOUT; ++rep) { pg8::Gemm g{MIX, Wl + W_OUT, M, DM, DM}; pg8::StaticOrder S; S.init(M, DM, G, bx);
                    pg8::EpiRes E{X, X, XB, SS, rep == REP_WOUT - 1 ? 1.0f : 0.0f, (LAS float*)(lds + EPI_OFF)}; pg8::gemm_phase<pg8::EpiRes, pg8::StaticOrder, false, true>(lds + RING_OFF, g, S, E); } SEAM(pb + 5); }
            }
            if (IN(pg)) { _Pragma("unroll 1") for (int rep = 0; rep < REP_GU; ++rep) { pg8::Gemm g{XB, Wl + (f ? W_GU2 : W_GU1), M, 2 * DFF, DM}; pg8::StaticOrder S; S.init(M, 2 * DFF, G, bx);
                pg8::EpiGU E{HQ, DFF, SS}; pg8::gemm_phase<pg8::EpiGU, pg8::StaticOrder, true, true>(lds + RING_OFF, g, S, E); } SEAM(pg); }
            if (IN(pg + 1)) { _Pragma("unroll 1") for (int rep = 0; rep < REP_DN; ++rep) { pg8::Gemm g{HQ, Wl + (f ? W_D2 : W_D1), M, DM, DFF}; pg8::StaticOrder S; S.init(M, DM, G, bx);
                pg8::EpiRes E{(l == 0 && f == 0) ? args.in[0] : X, X, XB, SS, rep == REP_DN - 1 ? 0.5f : 0.0f, (LAS float*)(lds + EPI_OFF)}; pg8::gemm_phase<pg8::EpiRes, pg8::StaticOrder, false, true>(lds + RING_OFF, g, S, E); } SEAM(pg + 1); }
        }
    }
    if (IN(PH_FINAL)) {
        FRESH_LANE(lane_f); const float* g = args.in[18];
        for (int row = gw; row < M; row += NGW) { GAS f32x4* xr = (GAS f32x4*)(X + (size_t)row * DM) + lane_f; const float r = pg8::rstd_of(SS, row);
#pragma unroll
            for (int j = 0; j < 4; ++j) { const f32x4 v = xr[64 * j]; const f32x4 gg = ((const f32x4*)g + lane_f)[64 * j]; xr[64 * j] = (f32x4){v.x * r * gg.x, v.y * r * gg.y, v.z * r * gg.z, v.w * r * gg.w}; } }
    }
#undef IN
#undef SEAM
}

#ifndef MK_PER_PHASE
#define MK_PER_PHASE 0
#endif
extern "C" void kernel_launch(void* const* d_in, const int* in_sizes, int n_in, void* d_out, int out_size, void* d_ws, size_t ws_size, hipStream_t stream) {
    static int grid = 0;
    if (grid == 0) {
        if (n_in != 19 || in_sizes[0] != M * DM || out_size != M * DM || ws_size < WS_END) { fprintf(stderr, "kernel_launch: unexpected shapes (n_in %d, ws %zu)\n", n_in, ws_size); grid = -1; return; }
        int dev = 0, cus = 0, per_cu = 0;
        if (hipGetDevice(&dev) != hipSuccess || hipDeviceGetAttribute(&cus, hipDeviceAttributeMultiprocessorCount, dev) != hipSuccess) { grid = -1; return; }
        if (hipFuncSetAttribute((const void*)mk_fwd, hipFuncAttributeMaxDynamicSharedMemorySize, LDS_BYTES) != hipSuccess) { fprintf(stderr, "kernel_launch: hipFuncSetAttribute failed\n"); grid = -1; return; }
        if (hipOccupancyMaxActiveBlocksPerMultiprocessor(&per_cu, (const void*)mk_fwd, NWAVES * 64, LDS_BYTES) != hipSuccess || per_cu < 1) { fprintf(stderr, "kernel_launch: occupancy query reports %d workgroups per CU\n", per_cu); (void)hipGetLastError(); grid = -1; return; }
        grid = cus;
    }
    if (grid < 0) return;
    if (hipMemsetAsync((char*)d_ws + WS_CTL, 0, CTL_ZERO_BYTES, stream) != hipSuccess) return;
    Args a{};
    for (int i = 0; i < 19; ++i) a.in[i] = (const float*)d_in[i];
    a.out = (float*)d_out; a.ws = (unsigned char*)d_ws;
#if MK_PER_PHASE
    for (int p = 0; p < N_PHASES; ++p) { a.ph_lo = p; a.ph_hi = p + 1; hipLaunchKernelGGL(mk_fwd, dim3(grid), dim3(NWAVES * 64), LDS_BYTES, stream, a); }
#else
    a.ph_lo = 0; a.ph_hi = N_PHASES;
    hipLaunchKernelGGL(mk_fwd, dim3(grid), dim3(NWAVES * 64), LDS_BYTES, stream, a);
#endif
}
```

```cpp
#include <hip/hip_runtime.h>
#include <cstdio>
#include <cstdint>
#include <cmath>

constexpr int BATCH = 4, SEQ = 4096, DM = 1024, DEPTH = 2, DFF = 2816, NQKV = 3072;
constexpr int M = BATCH * SEQ;
constexpr float EPS = 1e-6f;
constexpr float LOG2E = 1.4426950408889634f;
constexpr float C2 = 0.125f * LOG2E;
constexpr int COL_QA = 0, COL_KA = 512, COL_VA = 1024, COL_QB = 1536, COL_KB = 2048, COL_VB = 2560;

typedef unsigned short bf16;
typedef unsigned v4u __attribute__((ext_vector_type(4)));
typedef unsigned v2u __attribute__((ext_vector_type(2)));

constexpr size_t MiB = 1u << 20;
constexpr size_t WS_CTL = 0, CTL_ZERO_BYTES = 1 * MiB;
constexpr int CW_BAR = 4096;
constexpr size_t WS_BT = 1 * MiB;
constexpr size_t WS_LAM = WS_BT + 16 * 4096 * 4;
constexpr size_t WS_SS = WS_LAM + 4096;
constexpr size_t WS_W = 2 * MiB;
constexpr size_t W_GU1 = 0, W_D1 = W_GU1 + (size_t)2 * DFF * DM, W_IN = W_D1 + (size_t)DM * DFF, W_OUT = W_IN + (size_t)NQKV * DM,
                 W_GU2 = W_OUT + (size_t)DM * DM, W_D2 = W_GU2 + (size_t)2 * DFF * DM, W_LAYER = W_D2 + (size_t)DM * DFF;
constexpr size_t WS_XB = 84 * MiB;
constexpr size_t WS_OD = WS_XB;
constexpr size_t WS_HQKV = 116 * MiB;
constexpr size_t WS_MIX = 212 * MiB;
constexpr size_t WS_END = 244 * MiB;
static_assert(WS_W + 2 * W_LAYER * 2 <= WS_XB, "weights fit");
static_assert(WS_SS + (size_t)M * 16 <= WS_W, "misc fits");

constexpr int LDS_BYTES = 163840;
constexpr int LDSCTL_OFF = LDS_BYTES - 512, MISC_OFF = LDSCTL_OFF + 64;
constexpr int EPI_OFF = LDSCTL_OFF - 4096;
constexpr int QS_OFF = EPI_OFF - 2048;
constexpr int RING_OFF = 0, RING_BYTES = QS_OFF;
static_assert(RING_BYTES >= 131072, "LDS map");
constexpr int CW_Q = 16384;
constexpr int NWAVES = 8;

__device__ __forceinline__ unsigned f2bf(float f) { unsigned u = __builtin_bit_cast(unsigned, f); return (u + 0x7fffu + ((u >> 16) & 1u)) >> 16; }
__device__ __forceinline__ unsigned pk2(float lo, float hi) { return f2bf(lo) | (f2bf(hi) << 16); }
__device__ __forceinline__ float bf2f(unsigned h) { return __builtin_bit_cast(float, h << 16); }
__device__ __forceinline__ float wave_sum(float v) {
#pragma unroll
    for (int o = 1; o < 64; o <<= 1) v += __shfl_xor(v, o);
    return v;
}
__device__ __forceinline__ float wave_max(float v) {
#pragma unroll
    for (int o = 1; o < 64; o <<= 1) v = fmaxf(v, __shfl_xor(v, o));
    return v;
}
namespace pg8 {
#define PG8_LAS __attribute__((address_space(3)))
typedef unsigned short bf16_t;
typedef short bf16x8 __attribute__((ext_vector_type(8)));
typedef float f32x4 __attribute__((ext_vector_type(4)));
typedef unsigned u32x4 __attribute__((ext_vector_type(4)));
constexpr int BM = 256, BK = 64, HALF = 128, HTB = HALF * BK * 2  , STAGE_BYTES = 8 * HTB, NXCD = 8, WGM = 8;

__host__ __device__ __forceinline__ int lds_byte(int r, int c) { const int st = (r >> 4) * 2 + (c >> 5), rr = r & 15, cc = c & 31, ob = rr * 64 + cc * 2; return st * 1024 + (ob ^ (((ob >> 9) & 1) << 5)); }
__host__ __device__ __forceinline__ void stage_rc(int b, int& R, int& C) { const int st = b / 1024, sb = b % 1024, swz = sb ^ (((sb >> 9) & 1) << 5); R = (st >> 1) * 16 + swz / 64; C = (st & 1) * 32 + (swz % 64) / 2; }
__host__ __device__ __forceinline__ int perm32(int rho) { const int n = rho >> 4, i = rho & 15; return 8 * (i >> 2) + 4 * n + (i & 3); }

struct Unit { int pm, pn; };
struct Gemm { const bf16_t* A; const bf16_t* Bt; int M, N, K; };

struct StaticOrder {
    int nM, nN, nwg, G, c;
    __host__ __device__ void init(int M, int N, int G_, int c_) { nM = M / BM; nN = N / BM; nwg = nM * nN; G = G_; c = c_; }
    __host__ __device__ bool next(int i, Unit& u) const {
        const long L = (long)i * G + c; if (L >= nwg) return false;
        int wgid = (int)L; { const int q = nwg / NXCD, r = nwg % NXCD, xcd = wgid % NXCD, off = wgid / NXCD; wgid = (xcd < r ? xcd * (q + 1) : r * (q + 1) + (xcd - r) * q) + off; }
        const int nig = WGM * nN, gid = wgid / nig, fm = gid * WGM, gsz = (nM - fm) < WGM ? (nM - fm) : WGM;
        u.pm = fm + ((wgid % nig) % gsz); u.pn = (wgid % nig) / gsz; return true;
    }
    __device__ __forceinline__ void a_ready(const Unit&) const {}
    __device__ __forceinline__ void done(const Unit&) const {}
};

__device__ __forceinline__ unsigned cvt_pk_bf16(float lo, float hi) { unsigned r; asm volatile("v_cvt_pk_bf16_f32 %0, %1, %2" : "=v"(r) : "v"(lo), "v"(hi)); return r; }
typedef float f32x2 __attribute__((ext_vector_type(2)));
typedef unsigned u32x2w __attribute__((ext_vector_type(2)));
__device__ __forceinline__ __amdgpu_buffer_rsrc_t wt_rsrc(const void* base, unsigned bytes) { return __builtin_amdgcn_make_buffer_rsrc((void*)base, 0, (int)bytes, 0x00020000); }
__device__ __forceinline__ void wt_store16(__amdgpu_buffer_rsrc_t rs, unsigned byte_off, u32x4 v) { __builtin_amdgcn_raw_buffer_store_b128(v, rs, byte_off, 0, 16); }
__device__ __forceinline__ void wt_store8(__amdgpu_buffer_rsrc_t rs, unsigned byte_off, u32x2w v) { __builtin_amdgcn_raw_buffer_store_b64(v, rs, byte_off, 0, 16); }
__device__ __forceinline__ float rstd_of(const float* SS, int row) { const f32x4 s = *(const f32x4*)(SS + (size_t)row * 4); return __builtin_amdgcn_rsqf(((s[0] + s[1]) + (s[2] + s[3])) * (1.0f / 1024.0f) + 1e-6f); }
__device__ __forceinline__ float silu_mul(float g, float u) { return g * u * __builtin_amdgcn_rcpf(1.0f + __builtin_amdgcn_exp2f(-1.4426950408889634f * g)); }
struct EpiGU {
    static constexpr bool PERM = true, AFTER_DRAIN = false;
    bf16_t* H; int ldh; const float* SS;
    __device__ __forceinline__ void operator()(const f32x4 (&acc)[2][2][4][2], const Unit& u, int wr, int wc, int fr, int fq, int wid, int lane) const {
        const int row0 = u.pm * BM + wr * 64 + fr, col0 = u.pn * HALF + wc * 32 + 8 * fq;
        const __amdgpu_buffer_rsrc_t rs = wt_rsrc(H, 16384u * 2816u * 2u);
        float rs_[2][4];
#pragma unroll
        for (int ai = 0; ai < 2; ++ai)
#pragma unroll
            for (int m = 0; m < 4; ++m) rs_[ai][m] = rstd_of(SS, row0 + ai * HALF + m * 16);
#pragma unroll
        for (int ai = 0; ai < 2; ++ai)
#pragma unroll
            for (int m = 0; m < 4; ++m) { const float r = rs_[ai][m]; const f32x4 g0 = acc[ai][0][m][0] * r, g1 = acc[ai][0][m][1] * r, u0 = acc[ai][1][m][0] * r, u1 = acc[ai][1][m][1] * r;
                u32x4 w; w.x = cvt_pk_bf16(silu_mul(g0[0], u0[0]), silu_mul(g0[1], u0[1])); w.y = cvt_pk_bf16(silu_mul(g0[2], u0[2]), silu_mul(g0[3], u0[3]));
                w.z = cvt_pk_bf16(silu_mul(g1[0], u1[0]), silu_mul(g1[1], u1[1])); w.w = cvt_pk_bf16(silu_mul(g1[2], u1[2]), silu_mul(g1[3], u1[3]));
                wt_store16(rs, (unsigned)(((row0 + ai * HALF + m * 16) * ldh + col0) * 2), w); }
    }
};
struct EpiQKV {
    static constexpr bool PERM = true, AFTER_DRAIN = false;
    bf16_t* O; int ldc; const float* SS;
    __device__ __forceinline__ void operator()(const f32x4 (&acc)[2][2][4][2], const Unit& u, int wr, int wc, int fr, int fq, int wid, int lane) const {
        const int row0 = u.pm * BM + wr * 64 + fr, col0 = u.pn * BM + wc * 32 + 8 * fq;
        const __amdgpu_buffer_rsrc_t ob = wt_rsrc(O, 16384u * 3072u * 2u);
        float rs[2][4];
#pragma unroll
        for (int ai = 0; ai < 2; ++ai)
#pragma unroll
            for (int m = 0; m < 4; ++m) rs[ai][m] = rstd_of(SS, row0 + ai * HALF + m * 16);
#pragma unroll
        for (int ai = 0; ai < 2; ++ai)
#pragma unroll
            for (int m = 0; m < 4; ++m) { const float r = rs[ai][m]; const unsigned rowb = (unsigned)(((row0 + ai * HALF + m * 16) * ldc + col0) * 2);
#pragma unroll
                for (int bj = 0; bj < 2; ++bj) { const f32x4 v0 = acc[ai][bj][m][0] * r, v1 = acc[ai][bj][m][1] * r;
                    u32x4 w; w.x = cvt_pk_bf16(v0[0], v0[1]); w.y = cvt_pk_bf16(v0[2], v0[3]); w.z = cvt_pk_bf16(v1[0], v1[1]); w.w = cvt_pk_bf16(v1[2], v1[3]);
                    wt_store16(ob, rowb + bj * HALF * 2, w); } }
    }
};
struct EpiRes {
    static constexpr bool PERM = false, AFTER_DRAIN = false;
    const float* Xin; float* X; bf16_t* XB; float* SS; float alpha; PG8_LAS float* P;
    __device__ __forceinline__ void operator()(const f32x4 (&acc)[2][2][4][2], const Unit& u, int wr, int wc, int fr, int fq, int wid, int lane) const {
        typedef unsigned u32x2v __attribute__((ext_vector_type(2)));
        const int col0 = u.pn * BM + wc * 32 + 4 * fq;
#pragma unroll
        for (int ai = 0; ai < 2; ++ai)
#pragma unroll
            for (int m = 0; m < 4; ++m) { const int r = ai * HALF + wr * 64 + m * 16 + fr; const size_t off = (size_t)(u.pm * BM + r) * 1024 + col0; float ss = 0.f;
#pragma unroll
                for (int bj = 0; bj < 2; ++bj)
#pragma unroll
                    for (int n = 0; n < 2; ++n) { const size_t o2 = off + bj * HALF + n * 16; const f32x4 xi = *(const f32x4*)(Xin + o2); const f32x4 xo = xi + acc[ai][bj][m][n] * alpha;
                        *(f32x4*)(X + o2) = xo; u32x2v w; w.x = cvt_pk_bf16(xo[0], xo[1]); w.y = cvt_pk_bf16(xo[2], xo[3]); *(u32x2v*)(XB + o2) = w;
                        ss += (xo[0] * xo[0] + xo[1] * xo[1]) + (xo[2] * xo[2] + xo[3] * xo[3]); }
                ss += __shfl_xor(ss, 16); ss += __shfl_xor(ss, 32);
                if (fq == 0) P[r * 4 + wc] = ss;
                if (m & 1) asm volatile("" ::: "memory"); }
        asm volatile("s_waitcnt lgkmcnt(0)" ::: "memory"); __builtin_amdgcn_s_barrier(); asm volatile("" ::: "memory");
        if (wc == 0 && fq == 0) {
#pragma unroll
            for (int ai = 0; ai < 2; ++ai)
#pragma unroll
                for (int m = 0; m < 4; ++m) { const int r = ai * HALF + wr * 64 + m * 16 + fr; const f32x4 p = *(const PG8_LAS f32x4*)(P + r * 4);
                    SS[(size_t)(u.pm * BM + r) * 4 + u.pn] = (p[0] + p[1]) + (p[2] + p[3]); }
        }
    }
};
template <class Epi, class Sched, bool ALIGN_EPI = false, bool SP2 = false>
__device__ __forceinline__ void gemm_phase(PG8_LAS unsigned char* lds, const Gemm g, const Sched& S, const Epi& E) {
    int tid_ = threadIdx.x; asm volatile("" : "+v"(tid_));
    const int tid = tid_, wid = __builtin_amdgcn_readfirstlane(tid >> 6), lane = tid & 63, wr = wid >> 2, wc = wid & 3, fr = lane & 15, fq = lane >> 4;
    const int K = g.K, nt = K / BK;
    unsigned voffA[2], voffB[2];
#pragma unroll
    for (int i = 0; i < 2; ++i) { int R, C; stage_rc(tid * 16 + i * 8192, R, C); const int Rb = Epi::PERM ? ((R & ~31) + perm32(R & 31)) : R;
        voffA[i] = (unsigned)(R * K + C) * 2u; voffB[i] = (unsigned)(Rb * K + C) * 2u; }
    const size_t kstep = (size_t)(BK * 2);
    const size_t hstep = (size_t)HALF * K * 2;
    const size_t tstep = 2 * hstep;
    const unsigned ldsw = (unsigned)wid * 1024u;
    const int aoff = lds_byte(wr * 64 + fr, fq * 8), boff = lds_byte(wc * 32 + fr, fq * 8);
#define PG8_SA(b, h) (((b) * 2 + (h)) * HTB)
#define PG8_SB(b, h) ((4 + (b) * 2 + (h)) * HTB)
#define PG8_STAGE(bufoff, gbase, voff) do { _Pragma("unroll") for (int _i = 0; _i < 2; ++_i) \
        __builtin_amdgcn_global_load_lds((const unsigned*)((const char*)(gbase) + (voff)[_i]), (PG8_LAS unsigned*)(lds + (bufoff) + ldsw + _i * 8192), 16, 0, 0); } while (0)
#define PG8_LDA(dst, b, h) do { _Pragma("unroll") for (int m = 0; m < 4; ++m) _Pragma("unroll") for (int k = 0; k < 2; ++k) dst[m][k] = *(const PG8_LAS bf16x8*)(lds + PG8_SA(b, h) + aoff + m * 2048 + k * 1024); } while (0)
#define PG8_LDB(dst, b, h) do { _Pragma("unroll") for (int n = 0; n < 2; ++n) _Pragma("unroll") for (int k = 0; k < 2; ++k) dst[n][k] = *(const PG8_LAS bf16x8*)(lds + PG8_SB(b, h) + boff + n * 2048 + k * 1024); } while (0)
#define PG8_MMA(ai, bj, At, Bt) do { __builtin_amdgcn_s_setprio(1); _Pragma("unroll") for (int m = 0; m < 4; ++m) _Pragma("unroll") for (int n = 0; n < 2; ++n) _Pragma("unroll") for (int k = 0; k < 2; ++k) \
        acc[ai][bj][m][n] = __builtin_amdgcn_mfma_f32_16x16x32_bf16(Bt[n][k], At[m][k], acc[ai][bj][m][n], 0, 0, 0); __builtin_amdgcn_s_setprio(0); } while (0)
#define PG8_WAIT_V(n) asm volatile("s_waitcnt vmcnt(" #n ")" ::: "memory")
#define PG8_WAIT_L(n) asm volatile("s_waitcnt lgkmcnt(" #n ")" ::: "memory")
#define PG8_BAR __builtin_amdgcn_s_barrier()
#define PG8_SCHED __builtin_amdgcn_sched_barrier(0)
    Unit cur, nxt; int ui = 0;
    if (!S.next(0, cur)) return;
    f32x4 acc[2][2][4][2];
#pragma unroll
    for (int a = 0; a < 2; ++a)
#pragma unroll
        for (int b = 0; b < 2; ++b)
#pragma unroll
            for (int m = 0; m < 4; ++m)
#pragma unroll
                for (int n = 0; n < 2; ++n) acc[a][b][m][n] = (f32x4){0.f, 0.f, 0.f, 0.f};
    bf16x8 At[4][2], B0[2][2], B1[2][2];
    const char* cA = (const char*)g.A + (size_t)cur.pm * tstep; const char* cB = (const char*)g.Bt + (size_t)cur.pn * tstep;
    S.a_ready(cur);
    if constexpr (SP2) {
        PG8_STAGE(PG8_SB(0, 0), cB, voffB); PG8_STAGE(PG8_SB(0, 1), cB + hstep, voffB); PG8_STAGE(PG8_SA(0, 0), cA, voffA); PG8_STAGE(PG8_SA(0, 1), cA + hstep, voffA);
        if (wr == 1) PG8_BAR;
        PG8_WAIT_V(2); PG8_BAR;
        PG8_STAGE(PG8_SB(1, 0), cB + kstep, voffB); PG8_STAGE(PG8_SA(1, 0), cA + kstep, voffA); PG8_STAGE(PG8_SB(1, 1), cB + hstep + kstep, voffB);
        PG8_WAIT_V(6); PG8_BAR;
    } else {
        PG8_STAGE(PG8_SB(0, 0), cB, voffB); PG8_STAGE(PG8_SA(0, 0), cA, voffA); PG8_STAGE(PG8_SB(0, 1), cB + hstep, voffB); PG8_STAGE(PG8_SA(0, 1), cA + hstep, voffA);
        if (wr == 1) PG8_BAR;
        PG8_WAIT_V(4); PG8_BAR;
        PG8_STAGE(PG8_SB(1, 0), cB + kstep, voffB); PG8_STAGE(PG8_SA(1, 0), cA + kstep, voffA); PG8_STAGE(PG8_SB(1, 1), cB + hstep + kstep, voffB);
        PG8_WAIT_V(6); PG8_BAR;
    }
    for (;;) {
        const bool has_next = S.next(ui + 1, nxt);
        const char* nA = has_next ? (const char*)g.A + (size_t)nxt.pm * tstep : cA; const char* nB = has_next ? (const char*)g.Bt + (size_t)nxt.pn * tstep : cB;
        for (int t = 0; t < nt; t += 2) {
            const bool last = (t == nt - 2);
            const char* a1 = cA + (size_t)(t + 1) * kstep;
            const char* a2 = last ? nA : cA + (size_t)(t + 2) * kstep; const char* b2 = last ? nB : cB + (size_t)(t + 2) * kstep;
            const char* a3 = a2 + kstep; const char* b3 = b2 + kstep;
            if (last && has_next) S.a_ready(nxt);
            if constexpr (SP2) {
            PG8_LDB(B0, 0, 0); PG8_LDB(B1, 0, 1); PG8_SCHED; PG8_LDA(At, 0, 0); PG8_STAGE(PG8_SA(1, 1), a1 + hstep, voffA);
            PG8_WAIT_V(8); PG8_WAIT_L(0); PG8_BAR; PG8_MMA(0, 0, At, B0); PG8_MMA(0, 1, At, B1); PG8_BAR; PG8_SCHED;
            PG8_LDA(At, 0, 1); PG8_STAGE(PG8_SB(0, 0), b2, voffB); PG8_STAGE(PG8_SB(0, 1), b2 + hstep, voffB); PG8_STAGE(PG8_SA(0, 0), a2, voffA);
            PG8_WAIT_V(8); PG8_WAIT_L(0); PG8_BAR; PG8_MMA(1, 0, At, B0); PG8_MMA(1, 1, At, B1); PG8_BAR; PG8_SCHED;
            PG8_LDB(B0, 1, 0); PG8_LDB(B1, 1, 1); PG8_SCHED; PG8_LDA(At, 1, 0); PG8_STAGE(PG8_SA(0, 1), a2 + hstep, voffA);
            PG8_WAIT_V(8); PG8_WAIT_L(0); PG8_BAR; PG8_MMA(0, 0, At, B0); PG8_MMA(0, 1, At, B1); PG8_BAR; PG8_SCHED;
            PG8_LDA(At, 1, 1); PG8_STAGE(PG8_SB(1, 0), b3, voffB); PG8_STAGE(PG8_SB(1, 1), b3 + hstep, voffB); PG8_STAGE(PG8_SA(1, 0), a3, voffA);
            PG8_WAIT_V(8); PG8_WAIT_L(0); PG8_BAR; PG8_MMA(1, 0, At, B0); PG8_MMA(1, 1, At, B1); PG8_BAR; PG8_SCHED;
            } else {
            PG8_LDB(B0, 0, 0); PG8_SCHED; PG8_LDA(At, 0, 0); PG8_STAGE(PG8_SA(1, 1), a1 + hstep, voffA);
            PG8_WAIT_L(8); PG8_BAR; PG8_WAIT_L(0); PG8_MMA(0, 0, At, B0); PG8_BAR; PG8_SCHED;
            PG8_LDB(B1, 0, 1); PG8_STAGE(PG8_SB(0, 0), b2, voffB);
            PG8_BAR; PG8_WAIT_L(0); PG8_MMA(0, 1, At, B1); PG8_BAR;
            PG8_LDA(At, 0, 1); PG8_STAGE(PG8_SA(0, 0), a2, voffA);
            PG8_BAR; PG8_WAIT_L(0); PG8_MMA(1, 0, At, B0); PG8_BAR; PG8_SCHED;
            PG8_STAGE(PG8_SB(0, 1), b2 + hstep, voffB);
            PG8_WAIT_V(6); PG8_BAR; PG8_MMA(1, 1, At, B1); PG8_BAR;
            PG8_LDB(B0, 1, 0); PG8_SCHED; PG8_LDA(At, 1, 0); PG8_STAGE(PG8_SA(0, 1), a2 + hstep, voffA);
            PG8_WAIT_L(8); PG8_BAR; PG8_WAIT_L(0); PG8_MMA(0, 0, At, B0); PG8_BAR; PG8_SCHED;
            PG8_LDB(B1, 1, 1); PG8_STAGE(PG8_SB(1, 0), b3, voffB);
            PG8_BAR; PG8_WAIT_L(0); PG8_MMA(0, 1, At, B1); PG8_BAR;
            PG8_LDA(At, 1, 1); PG8_STAGE(PG8_SA(1, 0), a3, voffA);
            PG8_BAR; PG8_WAIT_L(0); PG8_MMA(1, 0, At, B0); PG8_BAR; PG8_SCHED;
            PG8_STAGE(PG8_SB(1, 1), b3 + hstep, voffB);
            PG8_WAIT_V(6); PG8_BAR; PG8_MMA(1, 1, At, B1); PG8_BAR;
            }
        }
        if constexpr (ALIGN_EPI) { if (wr == 0) PG8_BAR; }
        if constexpr (!Epi::AFTER_DRAIN) { E(acc, cur, wr, wc, fr, fq, wid, lane); S.done(cur); }
        if (!has_next) break;
#pragma unroll
        for (int a = 0; a < 2; ++a)
#pragma unroll
            for (int b = 0; b < 2; ++b)
#pragma unroll
                for (int m = 0; m < 4; ++m)
#pragma unroll
                    for (int n = 0; n < 2; ++n) acc[a][b][m][n] = (f32x4){0.f, 0.f, 0.f, 0.f};
        cur = nxt; cA = nA; cB = nB; ++ui;
        if constexpr (ALIGN_EPI) { if (wr == 1) PG8_BAR; }
    }
    PG8_WAIT_V(0);
    if constexpr (!ALIGN_EPI) { if (wr == 0) PG8_BAR; }
    PG8_BAR;
    if constexpr (Epi::AFTER_DRAIN) { E.fused(acc, cur, wr, wc, fr, fq, lds, wid, lane); S.done(cur); }
#undef PG8_SA
#undef PG8_SB
#undef PG8_STAGE
#undef PG8_LDA
#undef PG8_LDB
#undef PG8_MMA
#undef PG8_WAIT_V
#undef PG8_WAIT_L
#undef PG8_BAR
#undef PG8_SCHED
}
}
#include <hip/hip_bf16.h>
namespace attn_body {
using bf16=__hip_bfloat16;
using bf16x8=__attribute__((ext_vector_type(8)))short;
using s16x4=__attribute__((ext_vector_type(4)))short;
using f32x16=__attribute__((ext_vector_type(16)))float;
using f32x4v=__attribute__((ext_vector_type(4)))float;
using u32x4=__attribute__((ext_vector_type(4)))unsigned;
constexpr int SEQ=4096,PQ=3072,PO=1024;
constexpr int NW=8,QBLK=32,QB=QBLK*NW,KVBLK=64;
__device__ __forceinline__ int crow(int r,int hi){return (r&3)+8*(r>>2)+4*hi;}
#define SBAR() __builtin_amdgcn_sched_barrier(0)
__device__ __forceinline__ void cmask(f32x16&p0,f32x16&p1,int jb,int qrel,int hi){
  const float NEG=-INFINITY; int kb=64*jb+4*hi;
  #pragma unroll
  for(int r=0;r<16;++r){int kv=kb+(r&3)+8*(r>>2); if(kv>qrel)p0[r]=NEG; if(kv+32>qrel)p1[r]=NEG;}
}
constexpr int NSLOT=3, SLOTB=8192;
constexpr int DTOP=2176, TB_NI=DTOP+320, TB_STRIDE=TB_NI*4+16;
template<int VD> struct Lay {
  static constexpr int VSLOT=SLOTB*(VD/64), LDS_K=0, LDS_V=NSLOT*SLOTB, LDS_WS=LDS_V+NSLOT*VSLOT, LDS_OST=LDS_WS+NW*64*4, LDS_TB=LDS_OST+NW*4096, LDS_BYTES=LDS_TB+4*TB_STRIDE;
};
__device__ __forceinline__ void glds16(const void*gsrc,unsigned lds_dst){unsigned keep;
  asm volatile("s_mov_b32 %0, m0\n\ts_mov_b32 m0, %2\n\ts_nop 0\n\tglobal_load_lds_dwordx4 %1, off\n\ts_mov_b32 m0, %0":"=&s"(keep):"v"(gsrc),"s"(lds_dst):"memory");}
__device__ __forceinline__ float fsub_s(float a,float b){float r;asm("v_sub_f32_e32 %0, %1, %2":"=v"(r):"v"(a),"v"(b));return r;}
typedef float f32x2_t __attribute__((ext_vector_type(2))); typedef __bf16 bf16x2_t __attribute__((ext_vector_type(2)));
__device__ __forceinline__ unsigned cvtpk_s(float lo,float hi){f32x2_t v={lo,hi};bf16x2_t b=__builtin_convertvector(v,bf16x2_t);return __builtin_bit_cast(unsigned,b);}
#define WAIT_BAR(N) asm volatile("s_waitcnt vmcnt(" #N ") lgkmcnt(0)\n\ts_barrier":::"memory")
typedef __attribute__((address_space(3))) const char* lds_cptr;
typedef short v4i16_t __attribute__((ext_vector_type(4)));
__device__ __forceinline__ void kload8(bf16x8*kf,lds_cptr kp){
  kf[0]=*(const __attribute__((address_space(3))) bf16x8*)(kp);      kf[1]=*(const __attribute__((address_space(3))) bf16x8*)(kp+512);
  kf[2]=*(const __attribute__((address_space(3))) bf16x8*)(kp+2048); kf[3]=*(const __attribute__((address_space(3))) bf16x8*)(kp+2560);
  kf[4]=*(const __attribute__((address_space(3))) bf16x8*)(kp+4096); kf[5]=*(const __attribute__((address_space(3))) bf16x8*)(kp+4608);
  kf[6]=*(const __attribute__((address_space(3))) bf16x8*)(kp+6144); kf[7]=*(const __attribute__((address_space(3))) bf16x8*)(kp+6656);
}
__device__ __forceinline__ void kload2(bf16x8*kf,lds_cptr kp,int j){ kf[2*j]=*(const __attribute__((address_space(3))) bf16x8*)(kp+j*2048); kf[2*j+1]=*(const __attribute__((address_space(3))) bf16x8*)(kp+j*2048+512); }
__device__ __forceinline__ s16x4 vtr(lds_cptr p){ return __builtin_bit_cast(s16x4,__builtin_amdgcn_ds_read_tr16_b64_v4i16((__attribute__((address_space(3))) v4i16_t*)p)); }
__device__ __forceinline__ void bload2(f32x16&c,lds_cptr bp,int off,int g){ const f32x4v v=*(const __attribute__((address_space(3))) f32x4v*)(bp+off+32*g); c[4*g]=v[0];c[4*g+1]=v[1];c[4*g+2]=v[2];c[4*g+3]=v[3]; }
__device__ __forceinline__ void bload16(f32x16&c0,f32x16&c1,lds_cptr bp){
  #pragma unroll
  for(int g=0;g<4;++g){bload2(c0,bp,0,g);bload2(c1,bp,128,g);} }
#define MX3(a,b,c) __builtin_fmaxf(__builtin_fmaxf((a),(b)),(c))
__device__ __forceinline__ float rowmax(const f32x16&p0,const f32x16&p1){
  float a=MX3(p0[0],p0[1],p1[0]),b=MX3(p0[2],p0[3],p1[1]);a=MX3(a,p1[2],p1[3]);
  #pragma unroll
  for(int r=4;r<16;r+=4){a=MX3(a,p0[r],p0[r+1]);b=MX3(b,p0[r+2],p0[r+3]);a=MX3(a,p1[r],p1[r+1]);b=MX3(b,p1[r+2],p1[r+3]);}
  float m=__builtin_fmaxf(a,b);
  auto rr=__builtin_amdgcn_permlane32_swap(__float_as_uint(m),__float_as_uint(m),false,false);
  return __builtin_fmaxf(__uint_as_float(rr[0]),__uint_as_float(rr[1]));
}
template<int ND> __device__ __forceinline__ void pv(f32x16*o,int vb,bf16x8 pa0,bf16x8 pa1,bf16x8 pa2,bf16x8 pa3){
  #pragma unroll
  for(int d0=0;d0<ND;++d0){s16x4 lo[4],hi[4];
    #pragma unroll
    for(int ks=0;ks<4;++ks){
      asm volatile("ds_read_b64_tr_b16 %0,%1 offset:%c2":"=&v"(lo[ks]):"v"(vb),"i"(d0*4096+ks*1024):"memory");
      asm volatile("ds_read_b64_tr_b16 %0,%1 offset:%c2":"=&v"(hi[ks]):"v"(vb),"i"(d0*4096+ks*1024+512):"memory");}
    asm volatile("s_waitcnt lgkmcnt(0)":::"memory");SBAR();
    #define PK(k) (bf16x8){lo[k][0],lo[k][1],lo[k][2],lo[k][3],hi[k][0],hi[k][1],hi[k][2],hi[k][3]}
    o[d0]=__builtin_amdgcn_mfma_f32_32x32x16_bf16(pa0,PK(0),o[d0],0,0,0);
    o[d0]=__builtin_amdgcn_mfma_f32_32x32x16_bf16(pa1,PK(1),o[d0],0,0,0);
    o[d0]=__builtin_amdgcn_mfma_f32_32x32x16_bf16(pa2,PK(2),o[d0],0,0,0);
    o[d0]=__builtin_amdgcn_mfma_f32_32x32x16_bf16(pa3,PK(3),o[d0],0,0,0);
    #undef PK
  }
}
struct AttnUnit { int qcol,kcol,vcol,ocol,c,b,qb,T0; bf16* O; };
template<int VD> __device__ __forceinline__ void build_bias(char*shm,const float*BT,int c){
  float*tb=(float*)(shm+Lay<VD>::LDS_TB); const float*bt=BT+c*4096;
  for(int e=threadIdx.x;e<4*TB_NI;e+=NW*64){ const int s=e/TB_NI,i=e-s*TB_NI,d=DTOP-i-s; tb[s*(TB_STRIDE/4)+i]=d>=0?bt[d]:0.f; }
}
template<int N> __device__ __forceinline__ void wait_bar(){ asm volatile("s_waitcnt vmcnt(%0) lgkmcnt(0)\n\ts_barrier"::"n"(N):"memory"); }
template<int VD,int THRL> __device__ __forceinline__ void attn_unit(const AttnUnit&u,const bf16*QKV,char*shm,unsigned*qhead,unsigned&ticket){
  using L=Lay<VD>; constexpr int ND=VD/32, VM=VD/64;
  #define WB(kc,vc) wait_bar<(kc)+(vc)*VM>()
  int tid_=threadIdx.x; asm volatile("":"+v"(tid_));
  const int tid=tid_,lane=tid&63,r32=lane&31,hi=lane>>5; const int wid=__builtin_amdgcn_readfirstlane(tid>>6);
  const long rowbase=(long)u.b*SEQ; const int q0=u.qb*QB;
  const bf16*Qw=QKV+(rowbase+q0+wid*QBLK)*PQ+u.qcol;
  const bf16*Kh=QKV+(rowbase+(long)u.T0*KVBLK)*PQ+u.kcol,*Vh=QKV+(rowbase+(long)u.T0*KVBLK)*PQ+u.vcol;
  const unsigned lds0=(unsigned)(uintptr_t)shm;
  float*wsf=(float*)(shm+L::LDS_WS)+wid*64;
  const bf16*ksrc=Kh+(long)lane*PQ+wid*8;
  const bf16*vsrc=Vh+(long)(16*(wid&3)+(lane>>2))*PQ+(wid>>2)*32+(lane&3)*8;
  const unsigned kdst=lds0+L::LDS_K+wid*1024, vdst=lds0+L::LDS_V+wid*1024;
  #define DMA_K(t,slot) glds16(ksrc+(long)(t)*KVBLK*PQ,(unsigned)__builtin_amdgcn_readfirstlane(kdst+(slot)))
  #define DMA_V(t,slot) do{ _Pragma("unroll") for(int i_=0;i_<VM;++i_) glds16(vsrc+(long)(t)*KVBLK*PQ+64*i_,(unsigned)__builtin_amdgcn_readfirstlane(vdst+(slot)*VM+8192*i_)); }while(0)
  const int vb0=(int)(lds0+L::LDS_V)+((lane>>4)&1)*32+(lane&3)*8+(4*hi+((lane&15)>>2))*64;
  bf16x8 kf[8];
  const lds_cptr shm3=(lds_cptr)shm; const lds_cptr kp0=shm3+L::LDS_K+hi*1024+r32*16; const lds_cptr vp0=shm3+L::LDS_V+((lane>>4)&1)*32+(lane&3)*8+(4*hi+((lane&15)>>2))*64;
  const int NT=(q0+QB)/KVBLK-u.T0;
  const int sft=(4-(r32&3))&3; const lds_cptr tbs=shm3+L::LDS_TB+sft*TB_STRIDE;
  int bnext=DTOP-(q0+wid*QBLK+r32)+KVBLK*u.T0+4*hi-sft;
  #define BPTR() (tbs+4*(bnext>0?bnext:0))
  DMA_K(0,0);DMA_V(0,0);DMA_K(1,SLOTB);
  bf16x8 qr[4];
  #pragma unroll
  for(int d0=0;d0<4;++d0)qr[d0]=*reinterpret_cast<const bf16x8*>(&Qw[(long)r32*PQ+d0*16+hi*8]);
  const lds_cptr qlp=shm3+L::LDS_OST+wid*4096+lane*16; bf16x8 qx=qr[0],qy=qr[1];
  if constexpr(VD==128){
    #pragma unroll
    for(int d0=0;d0<4;++d0)*(__attribute__((address_space(3))) bf16x8*)(shm3+L::LDS_OST+wid*4096+lane*16+d0*1024)=qr[d0]; }
  #define QF(d0) (VD==128?(((d0)&1)?qy:qx):qr[d0])
  #define QLD(d0) do{ if constexpr(VD==128){ (((d0)&1)?qy:qx)=*(const __attribute__((address_space(3))) bf16x8*)(qlp+(d0)*1024); SBAR(); } }while(0)
  float mhat=0.f,l_reg=0.f;f32x16 o[ND];
  #pragma unroll
  for(int d_=0;d_<ND;++d_)o[d_]=f32x16{};
  const int qrel=wid*QBLK+r32;
  #define CMASK(P0,P1,t) do{int jb_=(t)-(NT-4); if(jb_>=0)cmask(P0,P1,jb_,qrel,hi);}while(0)
  bool resc=false;
  #define RESC() do{ if(resc){ asm volatile("s_waitcnt lgkmcnt(0)":::"memory"); \
      _Pragma("unroll") for(int d_=0;d_<ND;++d_) _Pragma("unroll") for(int r=0;r<16;++r)o[d_][r]*=wsf[crow(r,hi)]; } }while(0)
  f32x16 pA0,pA1,pB0,pB1;
  int sl_prev=0,sl_cur=0,sl_next=SLOTB;
  #define ROT() do{sl_prev=sl_cur;sl_cur=sl_next;sl_next=(sl_next==(NSLOT-1)*SLOTB)?0:sl_next+SLOTB;}while(0)
  DMA_K(2,2*SLOTB);
  WB(2,1);
  bload16(pA0,pA1,BPTR()); bnext+=KVBLK;
  { const char*kb=shm+L::LDS_K+hi*1024+r32*16;
    #pragma unroll
    for(int d0=0;d0<4;++d0){ const bf16x8 b0=*reinterpret_cast<const bf16x8*>(kb+d0*2048); const bf16x8 b1=*reinterpret_cast<const bf16x8*>(kb+d0*2048+512);
      pA0=__builtin_amdgcn_mfma_f32_32x32x16_bf16(b0,qr[d0],pA0,0,0,0); pA1=__builtin_amdgcn_mfma_f32_32x32x16_bf16(b1,qr[d0],pA1,0,0,0);} }
  asm volatile("s_nop 15\n\ts_nop 7":"+v"(pA0),"+v"(pA1));CMASK(pA0,pA1,0);
  { const float rm=rowmax(pA0,pA1); mhat=__builtin_fmaxf(rm,-1e30f);
    _Pragma("unroll") for(int r=0;r<16;++r){pA0[r]=__builtin_amdgcn_exp2f(fsub_s(pA0[r],mhat));}
    _Pragma("unroll") for(int r=0;r<16;++r){pA1[r]=__builtin_amdgcn_exp2f(fsub_s(pA1[r],mhat));} }
  WB(0,0);
  DMA_K(3,0);DMA_V(1,SLOTB);
  ROT();
  kload8(kf,kp0+sl_cur);
  bload16(pB0,pB1,BPTR()); bnext+=KVBLK;
  WB(1,1);
  s16x4 vlo[8],vhi[8]; u32x4 pw0,pw1,pw2,pw3;
  #define PKW(P,B) cvtpk_s(P[B],P[B+1])
  #define PAF(k) __builtin_bit_cast(bf16x8,pw##k)
  #define VFR(i) (bf16x8){vlo[i][0],vlo[i][1],vlo[i][2],vlo[i][3],vhi[i][0],vhi[i][1],vhi[i][2],vhi[i][3]}
  #define PIN(x) asm volatile("":"+v"(x))
  #define GAPA(MF,A0,A1,A2,A3,W0,W1,PW) do{ MF; sacc+=A0; sacc+=A1; sacc+=A2; sacc+=A3; PIN(sacc); W0; W1; PIN(PW); SBAR(); }while(0)
  #define EX(v) __builtin_amdgcn_exp2f(fsub_s(v,mhat))
  #define GAPB(MF,X,B) do{ MF; X[B]=EX(X[B]); X[B+1]=EX(X[B+1]); X[B+2]=EX(X[B+2]); X[B+3]=EX(X[B+3]); PIN(X); SBAR(); }while(0)
  #define GAPB2(MF,X,B) do{ MF; X[B]=EX(X[B]); X[B+1]=EX(X[B+1]); PIN(X); SBAR(); }while(0)
  #define VRDF(sl,d0,ks) do{ vlo[sl]=vtr(vp_+((d0)*4096+(ks)*1024)); vhi[sl]=vtr(vp_+((d0)*4096+(ks)*1024+512)); }while(0)
  #define KRD(G,j) do{ if(G){ kload2(kf,kp0+sl_next,j); SBAR(); } }while(0)
  #define BRD(G,P,off,g) do{ if(G){ bload2(P,bp_,off,g); bload2(P,bp_,off,(g)+1); SBAR(); } }while(0)
  #define MF32(a,b,c) __builtin_amdgcn_mfma_f32_32x32x16_bf16(a,b,c,0,0,0)
  #define VA64(j) VRDF(((j)>>1)+4*((j)&1),(j)&1,(j)>>1)
  #define VA128(j) VRDF(j,(j)&3,(j)>>2)
  #define PHASE_A(C0,C1,P0,P1,VA) \
    VA(0); SBAR(); float sacc=(P0[0]+P0[1]); \
    QLD(1); GAPA(C0=MF32(kf[0],QF(0),C0), P0[2],P0[3],P0[4],P0[5],     pw0[0]=PKW(P0,0), pw0[1]=PKW(P0,2), pw0); \
    VA(1); SBAR(); GAPA(C1=MF32(kf[1],QF(0),C1), P0[6],P0[7],P0[8],P0[9],     pw0[2]=PKW(P0,4), pw0[3]=PKW(P0,6), pw0); \
    VA(2); SBAR(); QLD(2); GAPA(C0=MF32(kf[2],QF(1),C0), P0[10],P0[11],P0[12],P0[13], pw1[0]=PKW(P0,8), pw1[1]=PKW(P0,10), pw1); \
    VA(3); SBAR(); GAPA(C1=MF32(kf[3],QF(1),C1), P0[14],P0[15],P1[0],P1[1],   pw1[2]=PKW(P0,12),pw1[3]=PKW(P0,14), pw1); \
    VA(4); SBAR(); QLD(3); GAPA(C0=MF32(kf[4],QF(2),C0), P1[2],P1[3],P1[4],P1[5],     pw2[0]=PKW(P1,0), pw2[1]=PKW(P1,2), pw2); \
    VA(5); SBAR(); GAPA(C1=MF32(kf[5],QF(2),C1), P1[6],P1[7],P1[8],P1[9],     pw2[2]=PKW(P1,4), pw2[3]=PKW(P1,6), pw2); \
    VA(6); SBAR(); GAPA(C0=MF32(kf[6],QF(3),C0), P1[10],P1[11],P1[12],P1[13], pw3[0]=PKW(P1,8), pw3[1]=PKW(P1,10), pw3); \
    VA(7); SBAR(); GAPA(C1=MF32(kf[7],QF(3),C1), P1[14],P1[15],0.f,0.f,       pw3[2]=PKW(P1,12),pw3[3]=PKW(P1,14), pw3); \
    l_reg+=sacc;
  #define DECIDE(C0,C1,t,GK,GV) \
    if(GK){DMA_K((t)+3,sl_cur);} if(GV){DMA_V((t)+1,sl_next);} \
    CMASK(C0,C1,t); \
    { float a=MX3(C0[0],C0[1],C1[0]),b=MX3(C0[2],C0[3],C1[1]); a=MX3(a,C1[2],C1[3]); \
      _Pragma("unroll") for(int r=4;r<16;r+=4){a=MX3(a,C0[r],C0[r+1]);b=MX3(b,C0[r+2],C0[r+3]);a=MX3(a,C1[r],C1[r+1]);b=MX3(b,C1[r+2],C1[r+3]);} \
      float rm=__builtin_fmaxf(a,b); { auto rr=__builtin_amdgcn_permlane32_swap(__float_as_uint(rm),__float_as_uint(rm),false,false); rm=__builtin_fmaxf(__uint_as_float(rr[0]),__uint_as_float(rr[1])); } \
      resc=false; \
      if(__builtin_expect(__any(rm-mhat>(float)THRL),0)){ const float mn=__builtin_fmaxf(rm,mhat); const float f=__builtin_amdgcn_exp2f(mhat-mn); mhat=mn; \
        l_reg*=f; if(hi==0)wsf[r32]=f; resc=true; } } \
    SBAR();
  #define STEP(C0,C1,P0,P1,t,GK,GV,GL) do{ SBAR(); \
    const lds_cptr vp_=vp0+sl_prev*VM; const lds_cptr bp_=BPTR(); \
    if constexpr(VD==64){ \
      PHASE_A(C0,C1,P0,P1,VA64) \
      DECIDE(C0,C1,t,GK,GV) \
      GAPB(o[0]=MF32(PAF(0),VFR(0),o[0]), C0,0); \
      BRD(GL,P0,0,0); GAPB(o[1]=MF32(PAF(0),VFR(4),o[1]), C0,4); \
      KRD(GL,0); GAPB(o[0]=MF32(PAF(1),VFR(1),o[0]), C0,8); \
      KRD(GL,1); GAPB(o[1]=MF32(PAF(1),VFR(5),o[1]), C0,12); \
      KRD(GL,2); GAPB(o[0]=MF32(PAF(2),VFR(2),o[0]), C1,0); \
      KRD(GL,3); GAPB(o[1]=MF32(PAF(2),VFR(6),o[1]), C1,4); \
      BRD(GL,P0,0,2); GAPB(o[0]=MF32(PAF(3),VFR(3),o[0]), C1,8); \
      BRD(GL,P1,128,0); GAPB(o[1]=MF32(PAF(3),VFR(7),o[1]), C1,12); \
      BRD(GL,P1,128,2); \
    } else { \
      PHASE_A(C0,C1,P0,P1,VA128) \
      DECIDE(C0,C1,t,GK,GV) \
        \
      GAPB2(o[0]=MF32(PAF(0),VFR(0),o[0]), C0,0);  VRDF(0,0,2); SBAR(); \
      GAPB2(o[1]=MF32(PAF(0),VFR(1),o[1]), C0,2);  VRDF(1,1,2); SBAR(); \
      GAPB2(o[2]=MF32(PAF(0),VFR(2),o[2]), C0,4);  VRDF(2,2,2); SBAR(); \
      GAPB2(o[3]=MF32(PAF(0),VFR(3),o[3]), C0,6);  VRDF(3,3,2); SBAR(); \
      KRD(GL,0); GAPB2(o[0]=MF32(PAF(1),VFR(4),o[0]), C0,8);  VRDF(4,0,3); SBAR(); \
      KRD(GL,1); GAPB2(o[1]=MF32(PAF(1),VFR(5),o[1]), C0,10); VRDF(5,1,3); SBAR(); \
      KRD(GL,2); GAPB2(o[2]=MF32(PAF(1),VFR(6),o[2]), C0,12); VRDF(6,2,3); SBAR(); \
      KRD(GL,3); GAPB2(o[3]=MF32(PAF(1),VFR(7),o[3]), C0,14); VRDF(7,3,3); SBAR(); \
      BRD(GL,P0,0,0); GAPB2(o[0]=MF32(PAF(2),VFR(0),o[0]), C1,0); \
      BRD(GL,P0,0,2); GAPB2(o[1]=MF32(PAF(2),VFR(1),o[1]), C1,2); \
      BRD(GL,P1,128,0); GAPB2(o[2]=MF32(PAF(2),VFR(2),o[2]), C1,4); \
      BRD(GL,P1,128,2); GAPB2(o[3]=MF32(PAF(2),VFR(3),o[3]), C1,6); \
      GAPB2(o[0]=MF32(PAF(3),VFR(4),o[0]), C1,8); \
      GAPB2(o[1]=MF32(PAF(3),VFR(5),o[1]), C1,10); \
      GAPB2(o[2]=MF32(PAF(3),VFR(6),o[2]), C1,12); \
      QLD(0); GAPB2(o[3]=MF32(PAF(3),VFR(7),o[3]), C1,14); \
    } \
    bnext+=KVBLK; \
    }while(0)
  int t=1;
  #undef CMASK
  #define CMASK(P0,P1,t) do{}while(0)
  for(;t+5<NT;t+=2){
    STEP(pB0,pB1,pA0,pA1,t,true,true,true);     WB(1,1); RESC(); ROT();
    STEP(pA0,pA1,pB0,pB1,t+1,true,true,true);   WB(1,1); RESC(); ROT();
  }
  #undef CMASK
  #define CMASK(P0,P1,t) do{int jb_=(t)-(NT-4); if(jb_>=0)cmask(P0,P1,jb_,qrel,hi);}while(0)
  #define ENDW(tt) do{ if((tt)+3<NT){WB(1,1);} else if((tt)+2<NT){WB(0,1);} else {WB(0,0);} }while(0)
  for(;t+1<NT;t+=2){
    STEP(pB0,pB1,pA0,pA1,t,(t+3<NT),(t+1<NT),(t+1<NT));       ENDW(t);   RESC(); ROT();
    STEP(pA0,pA1,pB0,pB1,t+1,(t+4<NT),(t+2<NT),(t+2<NT));     ENDW(t+1); RESC(); ROT();
  }
  STEP(pB0,pB1,pA0,pA1,NT-1,false,false,false); RESC();
  if(tid==0)ticket=__hip_atomic_fetch_add(qhead,1u,__ATOMIC_RELAXED,__HIP_MEMORY_SCOPE_AGENT);
  { float sacc=pB0[0]+pB0[1]; _Pragma("unroll") for(int r=2;r<16;++r)sacc+=pB0[r]; _Pragma("unroll") for(int r=0;r<16;++r)sacc+=pB1[r]; l_reg+=sacc;
    pw0=(u32x4){PKW(pB0,0),PKW(pB0,2),PKW(pB0,4),PKW(pB0,6)};pw1=(u32x4){PKW(pB0,8),PKW(pB0,10),PKW(pB0,12),PKW(pB0,14)};pw2=(u32x4){PKW(pB1,0),PKW(pB1,2),PKW(pB1,4),PKW(pB1,6)};pw3=(u32x4){PKW(pB1,8),PKW(pB1,10),PKW(pB1,12),PKW(pB1,14)};
    SBAR(); pv<ND>(o,vb0+sl_cur*VM,PAF(0),PAF(1),PAF(2),PAF(3)); }
  {auto rr=__builtin_amdgcn_permlane32_swap(__float_as_uint(l_reg),__float_as_uint(l_reg),false,false);l_reg=__uint_as_float(rr[0])+__uint_as_float(rr[1]);}
  if(hi==0)wsf[32+r32]=l_reg;asm volatile("s_waitcnt lgkmcnt(0)":::"memory");
  float rli[16];
  #pragma unroll
  for(int r=0;r<16;++r)rli[r]=__builtin_amdgcn_rcpf(wsf[32+crow(r,hi)]);
  bf16*Ow=u.O+(rowbase+q0+wid*QBLK)*PO+u.ocol; const __amdgpu_buffer_rsrc_t orsrc=__builtin_amdgcn_make_buffer_rsrc((void*)Ow,0,QBLK*PO*2,0x00020000);
  { bf16*stg=(bf16*)(shm+L::LDS_OST)+wid*2048;
    #pragma unroll
    for(int p=0;p<VM;++p){
      #pragma unroll
      for(int r=0;r<16;++r){const int orow=crow(r,hi);
        #pragma unroll
        for(int d0=0;d0<2;++d0)stg[orow*64+d0*32+r32]=__float2bfloat16(o[2*p+d0][r]*rli[r]);}
      asm volatile("s_waitcnt lgkmcnt(0)":::"memory");
      #pragma unroll
      for(int i=0;i<4;++i){const int row=i*8+(lane>>3),ch=lane&7; const u32x4 v=*(const u32x4*)(stg+row*64+ch*8); __builtin_amdgcn_raw_buffer_store_b128(v,orsrc,(unsigned)((row*PO+p*64+ch*8)*2),0,16);}
      asm volatile("s_waitcnt lgkmcnt(0)":::"memory"); } }
  asm volatile("s_waitcnt lgkmcnt(0)\n\ts_barrier":::"memory");
  #undef PKW
  #undef PAF
  #undef VFR
  #undef PIN
  #undef GAPA
  #undef GAPB
  #undef GAPB2
  #undef EX
  #undef VRDF
  #undef KRD
  #undef BRD
  #undef MF32
  #undef PHASE_A
  #undef QF
  #undef QLD
  #undef VA64
  #undef VA128
  #undef DECIDE
  #undef STEP
  #undef ENDW
  #undef DMA_K
  #undef DMA_V
  #undef CMASK
  #undef RESC
  #undef ROT
  #undef BPTR
  #undef WB
}
constexpr int ATTN_LDS_BYTES=Lay<128>::LDS_BYTES;
#undef SBAR
#undef WAIT_BAR
#undef MX3
}
#define GAS __attribute__((address_space(1)))
#define LAS __attribute__((address_space(3)))
typedef unsigned short bf16;
typedef unsigned v4u __attribute__((ext_vector_type(4)));
typedef float f32x4 __attribute__((ext_vector_type(4)));
typedef short bf16x8 __attribute__((ext_vector_type(8)));
typedef GAS unsigned gu32;
typedef GAS unsigned long long gu64;
#define RLX_AGENT __ATOMIC_RELAXED, __HIP_MEMORY_SCOPE_AGENT
#define LDS_WAIT() asm volatile("s_waitcnt lgkmcnt(0)" ::: "memory")
#define VM_WAIT() asm volatile("s_waitcnt vmcnt(0)" ::: "memory")
__device__ __forceinline__ unsigned long long rt() { return __builtin_amdgcn_s_memrealtime(); }

#define XB_TMO      128
#define XB_XCNT(j)  (256  + 64 * (j))
#define XB_XSUB(j)  (1280 + 64 * (j))
#define XB_XGEN(j)  (2304 + 64 * (j))
#define XB_TOP      3328
#define XB_TOPGEN   3392
#define XCD_BAR_WORDS 3456
#define XB_SPIN_CAP (1u << 18)

__device__ __forceinline__ unsigned xb_ld(unsigned* p)              { return __hip_atomic_load(p, __ATOMIC_RELAXED, __HIP_MEMORY_SCOPE_AGENT); }
__device__ __forceinline__ unsigned xb_add(unsigned* p, unsigned v) { return __hip_atomic_fetch_add(p, v, __ATOMIC_RELAXED, __HIP_MEMORY_SCOPE_AGENT); }
__device__ __forceinline__ unsigned xb_xcc_id() { return (unsigned)__builtin_amdgcn_s_getreg((3 << 11) | 20) & 0xFu; }
#define XB_SPIN(cond, bar) do { unsigned _sp = 0; while (cond) { __builtin_amdgcn_s_sleep(1); \
    if ((++_sp & 255u) == 0u) { if (xb_ld(&(bar)[XB_TMO])) break; if (_sp > XB_SPIN_CAP) { atomicAdd(&(bar)[XB_TMO], 1u); break; } } } } while (0)

struct XcdBarrier {
    unsigned* bar; unsigned x;
    volatile LAS unsigned* st;
};

__device__ __forceinline__ XcdBarrier xcd_barrier_post(unsigned* bar, volatile LAS unsigned* st) {
    XcdBarrier b; b.bar = bar; b.x = xb_xcc_id(); b.st = st;
    if (threadIdx.x == 0) (void)xb_add(&bar[XB_XCNT(b.x)], 1u);
    return b;
}
__device__ __forceinline__ void xcd_barrier_complete(unsigned* bar, unsigned x, unsigned& nloc, unsigned& nx) {
    const unsigned G = gridDim.x * gridDim.y * gridDim.z;
    unsigned sum, cnt, mine, sp = 0u;
    for (;;) {
        sum = 0u; cnt = 0u; mine = 0u;
#pragma unroll
        for (unsigned j = 0; j < 16; ++j) { const unsigned c = xb_ld(&bar[XB_XCNT(j)]); sum += c; cnt += (c > 0u) ? 1u : 0u; mine = (j == x) ? c : mine; }
        if (sum == G) break;
        __builtin_amdgcn_s_sleep(1);
        if ((++sp & 255u) == 0u) { if (xb_ld(&bar[XB_TMO])) break; if (sp > XB_SPIN_CAP) { atomicAdd(&bar[XB_TMO], 1u); break; } }
    }
    nloc = mine > 0u ? mine : 1u; nx = cnt > 0u ? cnt : 1u;
}

__device__ __forceinline__ void xcd_barrier(const XcdBarrier& b) {
    asm volatile("s_waitcnt vmcnt(0)" ::: "memory");
    __syncthreads();
    if (threadIdx.x == 0) {
        unsigned* bar = b.bar;
        __builtin_amdgcn_s_waitcnt(0);
        unsigned nloc = b.st[0], nx = b.st[1];
        if (nloc == 0u) { xcd_barrier_complete(bar, b.x, nloc, nx); b.st[0] = nloc; b.st[1] = nx; }
        const unsigned old = xb_add(&bar[XB_XSUB(b.x)], 1u);
        const unsigned gen = old / nloc;
        if (old + 1u == (gen + 1u) * nloc) {
            __builtin_amdgcn_fence(__ATOMIC_RELEASE, "agent");
            asm volatile("s_waitcnt vmcnt(0)" ::: "memory");
            const unsigned og = xb_add(&bar[XB_TOP], 1u);
            const unsigned tg = og / nx;
            if (og + 1u == (tg + 1u) * nx) xb_add(&bar[XB_TOPGEN], 1u);
            else XB_SPIN(xb_ld(&bar[XB_TOPGEN]) == tg, bar);
            __builtin_amdgcn_fence(__ATOMIC_ACQUIRE, "agent");
            xb_add(&bar[XB_XGEN(b.x)], 1u);
            asm volatile("s_waitcnt vmcnt(0)" ::: "memory");
        } else {
            XB_SPIN(xb_ld(&bar[XB_XGEN(b.x)]) == gen, bar);
            __builtin_amdgcn_fence(__ATOMIC_ACQUIRE, "agent");
            asm volatile("s_waitcnt vmcnt(0)" ::: "memory");
        }
    }
    __syncthreads();
}
__device__ __forceinline__ int t5_bucket(int d) {
    if (d < 16) return d < 0 ? 0 : d;
    int b = 16;
    b += (d >= 22); b += (d >= 30); b += (d >= 40); b += (d >= 54); b += (d >= 73); b += (d >= 99); b += (d >= 134); b += (d >= 182);
    b += (d >= 246); b += (d >= 332); b += (d >= 450); b += (d >= 609); b += (d >= 825); b += (d >= 1117); b += (d >= 1513);
    return b;
}
__device__ __forceinline__ void p0_transpose_item(const float* W, const float* g, int K, int N, bf16* WT, int kind, LAS float* scr, int item, int lane) {
    const int nblk = N / 64, kb = item / nblk, nb = item % nblk, k0 = 64 * kb, n0 = 64 * nb;
    float sc = 1.f; if (kind == 3 && ((n0 >= COL_QA && n0 < COL_KA) || (n0 >= COL_QB && n0 < COL_KB))) sc = C2;
    const int lk = lane >> 4, ln = (lane & 15) * 4;
    f32x4 v[16];
#pragma unroll
    for (int i = 0; i < 16; ++i) v[i] = *(const GAS f32x4*)(W + (size_t)(k0 + 4 * i + lk) * N + n0 + ln);
#pragma unroll
    for (int i = 0; i < 16; ++i) { const int kk = 4 * i + lk; const float gk = g ? g[k0 + kk] * sc : sc; LAS float* d = scr + kk * 65 + ln; d[0] = v[i].x * gk; d[1] = v[i].y * gk; d[2] = v[i].z * gk; d[3] = v[i].w * gk; }
    LDS_WAIT(); asm volatile("" ::: "memory");
    int r0 = n0; if (kind == 1) r0 = (n0 / 128) * 256 + (n0 % 128); else if (kind == 2) r0 = (n0 / 128) * 256 + 128 + (n0 % 128);
    const int c = lane & 7;
#pragma unroll
    for (int j = 0; j < 8; ++j) { const int n = (lane >> 3) + 8 * j; const LAS float* s = scr + (8 * c) * 65 + n;
        v4u o; o.x = pk2(s[0 * 65], s[1 * 65]); o.y = pk2(s[2 * 65], s[3 * 65]); o.z = pk2(s[4 * 65], s[5 * 65]); o.w = pk2(s[6 * 65], s[7 * 65]);
        *(GAS v4u*)(WT + (size_t)(r0 + n) * K + k0 + 8 * c) = o; }
    LDS_WAIT(); asm volatile("" ::: "memory");
}

struct Args { const float* in[19]; float* out; unsigned char* ws; int ph_lo, ph_hi; };
constexpr int PH_PRO = 0, PH_L0 = 1, PH_PER_LAYER = 8, PH_FINAL = PH_L0 + DEPTH * PH_PER_LAYER, N_PHASES = PH_FINAL + 1;

__device__ __forceinline__ void attn_naive_item(const bf16* QKV, const float* BT, bf16* OD, bf16* MIX, LAS float* sc, LAS float* qs, int job, int t, int lane) {
    const bool dil = job >= 32; int b, qcol, kcol, vcol, ocol, c; bf16* O;
    if (!dil) { const int m = job & 1, h = (job >> 1) & 3; b = job >> 3; qcol = COL_QA + h * 128 + m * 64; kcol = COL_KA + h * 128 + m * 64; vcol = COL_VA + h * 128; ocol = m * 512 + h * 128; c = h * 2 + m; O = OD; }
    else { const int j = job - 32, h = j & 7; b = j >> 3; qcol = COL_QB + h * 64; kcol = COL_KB + h * 64; vcol = COL_VB + h * 64; ocol = 512 + h * 64; c = 8 + h; O = MIX; }
    const size_t rb = (size_t)b * SEQ;
    qs[lane] = bf2f(QKV[(rb + t) * NQKV + qcol + lane]);
    LDS_WAIT(); asm volatile("" ::: "memory");
    const int lo = dil ? (t > 2048 ? t - 2048 : 0) : 0, n = t - lo + 1;
    const float* bt = BT + c * 4096;
    float mx = -INFINITY;
    for (int kk = lane; kk < n; kk += 64) { const int k = lo + kk; const v4u* kr = (const v4u*)(QKV + (rb + k) * NQKV + kcol); float s = 0.f;
#pragma unroll
        for (int j = 0; j < 8; ++j) { const v4u u = kr[j]; const LAS float* q = qs + j * 8;
            s += q[0] * bf2f(u.x & 0xffff) + q[1] * bf2f(u.x >> 16) + q[2] * bf2f(u.y & 0xffff) + q[3] * bf2f(u.y >> 16) + q[4] * bf2f(u.z & 0xffff) + q[5] * bf2f(u.z >> 16) + q[6] * bf2f(u.w & 0xffff) + q[7] * bf2f(u.w >> 16); }
        s += bt[t - k]; sc[kk] = s; mx = fmaxf(mx, s); }
    mx = wave_max(mx); float l = 0.f;
    for (int kk = lane; kk < n; kk += 64) { const float p = exp2f(sc[kk] - mx); sc[kk] = p; l += p; }
    l = wave_sum(l);
    LDS_WAIT(); asm volatile("" ::: "memory");
    const float il = 1.f / l;
    if (!dil) { float o0 = 0.f, o1 = 0.f;
        for (int kk = 0; kk < n; ++kk) { const float p = sc[kk]; const unsigned u = *(const unsigned*)(QKV + (rb + lo + kk) * NQKV + vcol + 2 * lane); o0 += p * bf2f(u & 0xffff); o1 += p * bf2f(u >> 16); }
        *(unsigned*)(O + (rb + t) * DM + ocol + 2 * lane) = pk2(o0 * il, o1 * il);
    } else { float o0 = 0.f;
        for (int kk = 0; kk < n; ++kk) { const float p = sc[kk]; o0 += p * bf2f(QKV[(rb + lo + kk) * NQKV + vcol + lane]); }
        O[(rb + t) * DM + ocol + lane] = (bf16)f2bf(o0 * il); }
    LDS_WAIT(); asm volatile("" ::: "memory");
}

struct QTab { unsigned char v[128]; };
constexpr QTab make_qtab() { QTab t{}; int cost[128] = {};
    for (int i = 0; i < 128; ++i) { const int kind = i >> 6, qb = i & 15; t.v[i] = (unsigned char)i; const int st = 4 * (qb + 1); cost[i] = kind == 0 ? st * 13 : (st < 36 ? st : 36) * 10; }
    for (int i = 0; i < 128; ++i) { int b = i; for (int j = i + 1; j < 128; ++j) if (cost[j] > cost[b]) b = j; const int c = cost[i]; cost[i] = cost[b]; cost[b] = c; const unsigned char v = t.v[i]; t.v[i] = t.v[b]; t.v[b] = v; }
    return t; }
__constant__ QTab QTAB = make_qtab();
#ifndef REP_GU
#define REP_GU 1
#endif
#ifndef REP_DN
#define REP_DN 1
#endif
#ifndef REP_QKV
#define REP_QKV 1
#endif
#ifndef REP_ATTN
#define REP_ATTN 1
#endif
#ifndef REP_COMB
#define REP_COMB 1
#endif
#ifndef REP_WOUT
#define REP_WOUT 1
#endif
#ifndef REP_PRO
#define REP_PRO 1
#endif
#ifndef MK_NAIVE_ATTN
#define MK_NAIVE_ATTN 0
#endif
__global__ void __launch_bounds__(NWAVES * 64, 2) mk_fwd(Args args) {
    extern __shared__ __attribute__((aligned(16))) unsigned char lds_raw[];
    LAS unsigned char* lds = (LAS unsigned char*)lds_raw;
    volatile LAS unsigned* MISC = (volatile LAS unsigned*)(lds + MISC_OFF);
    const int tid = threadIdx.x, lane = tid & 63, wave = __builtin_amdgcn_readfirstlane(tid >> 6);
    const int G = gridDim.x; const int bx = blockIdx.x; const int vcu = (G % 8 == 0) ? (bx % 8) * (G / 8) + bx / 8 : bx;
    unsigned char* ws = args.ws;
    gu32* ctl = (gu32*)(ws + WS_CTL);
    float* X = args.out; float* BT = (float*)(ws + WS_BT); float* LAM = (float*)(ws + WS_LAM); float* SS = (float*)(ws + WS_SS);
    bf16* W = (bf16*)(ws + WS_W); bf16* XB = (bf16*)(ws + WS_XB); bf16* OD = (bf16*)(ws + WS_OD); bf16* HQ = (bf16*)(ws + WS_HQKV); bf16* MIX = (bf16*)(ws + WS_MIX);
    for (int u = tid; u < (LDS_BYTES - LDSCTL_OFF) / 4; u += NWAVES * 64) ((LAS unsigned*)(lds + LDSCTL_OFF))[u] = 0u;
    __syncthreads();
    const int lo = args.ph_lo, hi = args.ph_hi;
    const bool multi = (hi - lo) > 1;
    XcdBarrier bar; bar.bar = (unsigned*)(ctl + CW_BAR); bar.x = 0; bar.st = nullptr;
    if (multi) bar = xcd_barrier_post((unsigned*)(ctl + CW_BAR), MISC + 8);
#define IN(k) (lo <= (k) && (k) < hi)
#define FRESH_LANE(name) int name = threadIdx.x; asm volatile("" : "+v"(name)); name &= 63
#define SEAM(k) do { if (IN((k) + 1)) xcd_barrier(bar); } while (0)
    const int gw = vcu * NWAVES + wave, NGW = G * NWAVES;

    if (IN(PH_PRO)) {
        for (int i = gw * 64 + lane; i < 16 * 4096; i += NGW * 64) { const int c = i >> 12, d = i & 4095;
            float v = LOG2E * args.in[17][t5_bucket(d) * 16 + c];
            if (c >= 8) { const int mult = (d <= 128 ? 1 : 0) + ((d % 4 == 0 && d <= 512) ? 1 : 0) + ((d % 16 == 0 && d <= 2048) ? 1 : 0); v = mult == 0 ? -INFINITY : v + __builtin_log2f((float)mult); }
            BT[i] = v; }
        if (gw < DEPTH) { const int l = gw; const float a = wave_sum(args.in[7][l * 64 + lane] * args.in[8][l * 64 + lane]), b = wave_sum(args.in[9][l * 64 + lane] * args.in[10][l * 64 + lane]);
            const float lam0 = 0.8f - 0.6f * __expf(-0.3f * (float)l); if (lane == 0) { LAM[l * 2 + 0] = __expf(a) - __expf(b) + lam0; LAM[l * 2 + 1] = 1.0f - lam0; } }
        _Pragma("unroll 1") for (int rep = 0; rep < REP_PRO; ++rep) {
        LAS float* scr = (LAS float*)(lds + RING_OFF + wave * 16640);
        constexpr int I_G = (DM / 64) * (DFF / 64), I_D = (DFF / 64) * (DM / 64), I_IN = (DM / 64) * (NQKV / 64), I_OUT = (DM / 64) * (DM / 64);
        constexpr int I_LAYER = 4 * I_G + 2 * I_D + I_IN + I_OUT;
        for (int it = gw; it < DEPTH * I_LAYER; it += NGW) {
            const int l = it / I_LAYER; int r = it % I_LAYER; bf16* Wl = W + (size_t)l * W_LAYER;
            if (r < I_G) { p0_transpose_item(args.in[2] + (size_t)l * DM * DFF, args.in[1] + l * DM, DM, DFF, Wl + W_GU1, 1, scr, r, lane); continue; } r -= I_G;
            if (r < I_G) { p0_transpose_item(args.in[3] + (size_t)l * DM * DFF, args.in[1] + l * DM, DM, DFF, Wl + W_GU1, 2, scr, r, lane); continue; } r -= I_G;
            if (r < I_D) { p0_transpose_item(args.in[4] + (size_t)l * DFF * DM, nullptr, DFF, DM, Wl + W_D1, 0, scr, r, lane); continue; } r -= I_D;
            if (r < I_IN) { p0_transpose_item(args.in[6] + (size_t)l * DM * NQKV, args.in[5] + l * DM, DM, NQKV, Wl + W_IN, 3, scr, r, lane); continue; } r -= I_IN;
            if (r < I_OUT) { p0_transpose_item(args.in[12] + (size_t)l * DM * DM, nullptr, DM, DM, Wl + W_OUT, 0, scr, r, lane); continue; } r -= I_OUT;
            if (r < I_G) { p0_transpose_item(args.in[14] + (size_t)l * DM * DFF, args.in[13] + l * DM, DM, DFF, Wl + W_GU2, 1, scr, r, lane); continue; } r -= I_G;
            if (r < I_G) { p0_transpose_item(args.in[15] + (size_t)l * DM * DFF, args.in[13] + l * DM, DM, DFF, Wl + W_GU2, 2, scr, r, lane); continue; } r -= I_G;
            p0_transpose_item(args.in[16] + (size_t)l * DFF * DM, nullptr, DFF, DM, Wl + W_D2, 0, scr, r, lane);
        }
        for (int row = gw; row < M; row += NGW) { const GAS f32x4* xr = (const GAS f32x4*)(args.in[0] + (size_t)row * DM) + lane; float s = 0.f; f32x4 v[4];
#pragma unroll
            for (int j = 0; j < 4; ++j) v[j] = xr[64 * j];
#pragma unroll
            for (int j = 0; j < 4; ++j) { s += (v[j].x * v[j].x + v[j].y * v[j].y) + (v[j].z * v[j].z + v[j].w * v[j].w); v2u o; o.x = pk2(v[j].x, v[j].y); o.y = pk2(v[j].z, v[j].w); ((GAS v2u*)(XB + (size_t)row * DM) + lane)[64 * j] = o; }
            s = wave_sum(s); if (lane == 0) *(GAS f32x4*)(SS + (size_t)row * 4) = (f32x4){s, 0.f, 0.f, 0.f}; }
        }
        SEAM(PH_PRO);
    }

#pragma unroll 1
    for (int l = 0; l < DEPTH; ++l) {
        const int pb = PH_L0 + l * PH_PER_LAYER; bf16* Wl = W + (size_t)l * W_LAYER;
#pragma unroll 1
        for (int f = 0; f < 2; ++f) {
            const int pg = pb + (f ? 6 : 0);
            if (f == 1) {
                if (IN(pb + 2)) { _Pragma("unroll 1") for (int rep = 0; rep < REP_QKV; ++rep) { pg8::Gemm g{XB, Wl + W_IN, M, NQKV, DM}; pg8::StaticOrder S; S.init(M, NQKV, G, bx);
                    pg8::EpiQKV E{HQ, NQKV, SS}; pg8::gemm_phase<pg8::EpiQKV, pg8::StaticOrder, true, true>(lds + RING_OFF, g, S, E); } SEAM(pb + 2); }
                if (IN(pb + 3)) {
#if MK_NAIVE_ATTN
                    FRESH_LANE(lane_l);
                    LAS float* sc = (LAS float*)(lds + RING_OFF + wave * 16384); LAS float* qs = (LAS float*)(lds + QS_OFF + wave * 256);
                    for (int i = gw, k = 0; i < 64 * SEQ; i += NGW, ++k) { const int job = i / SEQ, tt = i % SEQ; const int t = (job & 1) ? (SEQ - 1 - tt) : tt;
                        attn_naive_item(HQ, BT, OD, MIX, sc, qs, job, t, lane_l); }
#else
                    int cur_c = -1; const int x0 = (int)(((long)vcu * 8) / G) & 7; gu32* qbase = ctl + CW_Q + l * 8 * 64;
                    _Pragma("unroll 1") for (int rep = 0; rep < REP_ATTN; ++rep)
                    for (int sq = 0; sq < 8; ++sq) { const int xq = (x0 + sq) & 7; gu32* qh = qbase + xq * 64 + rep * 16;
                        if (tid == 0) MISC[12] = __hip_atomic_fetch_add(qh, 1u, RLX_AGENT);
                        __syncthreads(); unsigned idx = (unsigned)__builtin_amdgcn_readfirstlane((int)MISC[12]); __syncthreads();
                        while (idx < 128u) {
                            unsigned nxt = 0u;
                            const unsigned code = QTAB.v[idx]; const int kind = code >> 6, hd = (code >> 4) & 3, qb = code & 15;
                            attn_body::AttnUnit u; u.qb = qb;
                            if (kind == 0) { const int e = 4 * xq + hd, mp = e & 1, h = (e >> 1) & 3; u.b = e >> 3; u.qcol = COL_QA + h * 128 + mp * 64; u.kcol = COL_KA + h * 128 + mp * 64; u.vcol = COL_VA + h * 128;
                                u.ocol = mp * 512 + h * 128; u.c = h * 2 + mp; u.T0 = 0; u.O = (attn_body::bf16*)OD;
                                if (u.c != cur_c) { attn_body::build_bias<128>((char*)lds_raw + RING_OFF, BT, u.c); cur_c = u.c; }
                                attn_body::attn_unit<128, 8>(u, (const attn_body::bf16*)HQ, (char*)lds_raw + RING_OFF, (unsigned*)qh, nxt); }
                            else { const int f = 4 * xq + hd, h = f & 7; u.b = f >> 3; u.qcol = COL_QB + h * 64; u.kcol = COL_KB + h * 64; u.vcol = COL_VB + h * 64; u.ocol = 512 + h * 64; u.c = 8 + h; u.T0 = qb > 8 ? 4 * qb - 32 : 0; u.O = (attn_body::bf16*)MIX;
                                if (u.c != cur_c) { attn_body::build_bias<64>((char*)lds_raw + RING_OFF, BT, u.c); cur_c = u.c; }
                                attn_body::attn_unit<64, 8>(u, (const attn_body::bf16*)HQ, (char*)lds_raw + RING_OFF, (unsigned*)qh, nxt); }
                            if (tid == 0) MISC[12] = nxt;
                            __syncthreads(); idx = (unsigned)__builtin_amdgcn_readfirstlane((int)MISC[12]); __syncthreads();
                        }
                    }
#endif
                    SEAM(pb + 3); }
                if (IN(pb + 4)) { FRESH_LANE(lane_l); const float lam = LAM[2 * l], oml = LAM[2 * l + 1]; const float* gain = args.in[11] + l * 128; const float g0 = gain[lane_l], g1 = gain[lane_l + 64];
                    _Pragma("unroll 1") for (int rep = 0; rep < REP_COMB; ++rep)
                    for (int item = gw; item < M * 4; item += NGW) { const int row = item >> 2, h = item & 3;
                        const bf16* o1 = OD + (size_t)row * DM + h * 128, *o2 = o1 + 512;
                        const float d0 = bf2f(o1[lane_l]) - lam * bf2f(o2[lane_l]), d1 = bf2f(o1[lane_l + 64]) - lam * bf2f(o2[lane_l + 64]);
                        const float r = __builtin_amdgcn_rsqf(wave_sum(d0 * d0 + d1 * d1) * (1.0f / 128.0f) + EPS) * oml;
                        MIX[(size_t)row * DM + h * 128 + lane_l] = (bf16)f2bf(d0 * r * g0); MIX[(size_t)row * DM + h * 128 + lane_l + 64] = (bf16)f2bf(d1 * r * g1); }
                    SEAM(pb + 4); }
                if (IN(pb + 5)) { _Pragma("unroll 1") for (int rep = 0; rep < REP_WOUT; ++rep) { pg8::Gemm g{MIX, Wl + W_OUT, M, DM, DM}; pg8::StaticOrder S; S.init(M, DM, G, bx);
                    pg8::EpiRes E{X, X, XB, SS, rep == REP_WOUT - 1 ? 1.0f : 0.0f, (LAS float*)(lds + EPI_OFF)}; pg8::gemm_phase<pg8::EpiRes, pg8::StaticOrder, false, true>(lds + RING_OFF, g, S, E); } SEAM(pb + 5); }
            }
            if (IN(pg)) { _Pragma("unroll 1") for (int rep = 0; rep < REP_GU; ++rep) { pg8::Gemm g{XB, Wl + (f ? W_GU2 : W_GU1), M, 2 * DFF, DM}; pg8::StaticOrder S; S.init(M, 2 * DFF, G, bx);
                pg8::EpiGU E{HQ, DFF, SS}; pg8::gemm_phase<pg8::EpiGU, pg8::StaticOrder, true, true>(lds + RING_OFF, g, S, E); } SEAM(pg); }
            if (IN(pg + 1)) { _Pragma("unroll 1") for (int rep = 0; rep < REP_DN; ++rep) { pg8::Gemm g{HQ, Wl + (f ? W_D2 : W_D1), M, DM, DFF}; pg8::StaticOrder S; S.init(M, DM, G, bx);
                pg8::EpiRes E{(l == 0 && f == 0) ? args.in[0] : X, X, XB, SS, rep == REP_DN - 1 ? 0.5f : 0.0f, (LAS float*)(lds + EPI_OFF)}; pg8::gemm_phase<pg8::EpiRes, pg8::StaticOrder, false, true>(lds + RING_OFF, g, S, E); } SEAM(pg + 1); }
        }
    }
    if (IN(PH_FINAL)) {
        FRESH_LANE(lane_f); const float* g = args.in[18];
        for (int row = gw; row < M; row += NGW) { GAS f32x4* xr = (GAS f32x4*)(X + (size_t)row * DM) + lane_f; const float r = pg8::rstd_of(SS, row);
#pragma unroll
            for (int j = 0; j < 4; ++j) { const f32x4 v = xr[64 * j]; const f32x4 gg = ((const f32x4*)g + lane_f)[64 * j]; xr[64 * j] = (f32x4){v.x * r * gg.x, v.y * r * gg.y, v.z * r * gg.z, v.w * r * gg.w}; } }
    }
#undef IN
#undef SEAM
}

#ifndef MK_PER_PHASE
#define MK_PER_PHASE 0
#endif
extern "C" void kernel_launch(void* const* d_in, const int* in_sizes, int n_in, void* d_out, int out_size, void* d_ws, size_t ws_size, hipStream_t stream) {
    static int grid = 0;
    if (grid == 0) {
        if (n_in != 19 || in_sizes[0] != M * DM || out_size != M * DM || ws_size < WS_END) { fprintf(stderr, "kernel_launch: unexpected shapes (n_in %d, ws %zu)\n", n_in, ws_size); grid = -1; return; }
        int dev = 0, cus = 0, per_cu = 0;
        if (hipGetDevice(&dev) != hipSuccess || hipDeviceGetAttribute(&cus, hipDeviceAttributeMultiprocessorCount, dev) != hipSuccess) { grid = -1; return; }
        if (hipFuncSetAttribute((const void*)mk_fwd, hipFuncAttributeMaxDynamicSharedMemorySize, LDS_BYTES) != hipSuccess) { fprintf(stderr, "kernel_launch: hipFuncSetAttribute failed\n"); grid = -1; return; }
        if (hipOccupancyMaxActiveBlocksPerMultiprocessor(&per_cu, (const void*)mk_fwd, NWAVES * 64, LDS_BYTES) != hipSuccess || per_cu < 1) { fprintf(stderr, "kernel_launch: occupancy query reports %d workgroups per CU\n", per_cu); (void)hipGetLastError(); grid = -1; return; }
        grid = cus;
    }
    if (grid < 0) return;
    if (hipMemsetAsync((char*)d_ws + WS_CTL, 0, CTL_ZERO_BYTES, stream) != hipSuccess) return;
    Args a{};
    for (int i = 0; i < 19; ++i) a.in[i] = (const float*)d_in[i];
    a.out = (float*)d_out; a.ws = (unsigned char*)d_ws;
#if MK_PER_PHASE
    for (int p = 0; p < N_PHASES; ++p) { a.ph_lo = p; a.ph_hi = p + 1; hipLaunchKernelGGL(mk_fwd, dim3(grid), dim3(NWAVES * 64), LDS_BYTES, stream, a); }
#else
    a.ph_lo = 0; a.ph_hi = N_PHASES;
    hipLaunchKernelGGL(mk_fwd, dim3(grid), dim3(NWAVES * 64), LDS_BYTES, stream, a);
#endif
}
```

```cpp
#include <hip/hip_runtime.h>
#include <cstdio>
#include <cstdint>
#include <cmath>

constexpr int BATCH = 4, SEQ = 4096, DM = 1024, DEPTH = 2, DFF = 2816, NQKV = 3072;
constexpr int M = BATCH * SEQ;
constexpr float EPS = 1e-6f;
constexpr float LOG2E = 1.4426950408889634f;
constexpr float C2 = 0.125f * LOG2E;
constexpr int COL_QA = 0, COL_KA = 512, COL_VA = 1024, COL_QB = 1536, COL_KB = 2048, COL_VB = 2560;

typedef unsigned short bf16;
typedef unsigned v4u __attribute__((ext_vector_type(4)));
typedef unsigned v2u __attribute__((ext_vector_type(2)));

constexpr size_t MiB = 1u << 20;
constexpr size_t WS_CTL = 0, CTL_ZERO_BYTES = 1 * MiB;
constexpr int CW_BAR = 4096;
constexpr size_t WS_BT = 1 * MiB;
constexpr size_t WS_LAM = WS_BT + 16 * 4096 * 4;
constexpr size_t WS_SS = WS_LAM + 4096;
constexpr size_t WS_W = 2 * MiB;
constexpr size_t W_GU1 = 0, W_D1 = W_GU1 + (size_t)2 * DFF * DM, W_IN = W_D1 + (size_t)DM * DFF, W_OUT = W_IN + (size_t)NQKV * DM,
                 W_GU2 = W_OUT + (size_t)DM * DM, W_D2 = W_GU2 + (size_t)2 * DFF * DM, W_LAYER = W_D2 + (size_t)DM * DFF;
constexpr size_t WS_XB = 84 * MiB;
constexpr size_t WS_OD = WS_XB;
constexpr size_t WS_HQKV = 116 * MiB;
constexpr size_t WS_MIX = 212 * MiB;
constexpr size_t WS_END = 244 * MiB;
static_assert(WS_W + 2 * W_LAYER * 2 <= WS_XB, "weights fit");
static_assert(WS_SS + (size_t)M * 16 <= WS_W, "misc fits");

constexpr int LDS_BYTES = 163840;
constexpr int LDSCTL_OFF = LDS_BYTES - 512, MISC_OFF = LDSCTL_OFF + 64;
constexpr int EPI_OFF = LDSCTL_OFF - 4096;
constexpr int QS_OFF = EPI_OFF - 2048;
constexpr int RING_OFF = 0, RING_BYTES = QS_OFF;
static_assert(RING_BYTES >= 131072, "LDS map");
constexpr int CW_Q = 16384;
constexpr int NWAVES = 8;

__device__ __forceinline__ unsigned f2bf(float f) { unsigned u = __builtin_bit_cast(unsigned, f); return (u + 0x7fffu + ((u >> 16) & 1u)) >> 16; }
__device__ __forceinline__ unsigned pk2(float lo, float hi) { return f2bf(lo) | (f2bf(hi) << 16); }
__device__ __forceinline__ float bf2f(unsigned h) { return __builtin_bit_cast(float, h << 16); }
__device__ __forceinline__ float wave_sum(float v) {
#pragma unroll
    for (int o = 1; o < 64; o <<= 1) v += __shfl_xor(v, o);
    return v;
}
__device__ __forceinline__ float wave_max(float v) {
#pragma unroll
    for (int o = 1; o < 64; o <<= 1) v = fmaxf(v, __shfl_xor(v, o));
    return v;
}
namespace pg8 {
#define PG8_LAS __attribute__((address_space(3)))
typedef unsigned short bf16_t;
typedef short bf16x8 __attribute__((ext_vector_type(8)));
typedef float f32x4 __attribute__((ext_vector_type(4)));
typedef unsigned u32x4 __attribute__((ext_vector_type(4)));
constexpr int BM = 256, BK = 64, HALF = 128, HTB = HALF * BK * 2  , STAGE_BYTES = 8 * HTB, NXCD = 8, WGM = 8;

__host__ __device__ __forceinline__ int lds_byte(int r, int c) { const int st = (r >> 4) * 2 + (c >> 5), rr = r & 15, cc = c & 31, ob = rr * 64 + cc * 2; return st * 1024 + (ob ^ (((ob >> 9) & 1) << 5)); }
__host__ __device__ __forceinline__ void stage_rc(int b, int& R, int& C) { const int st = b / 1024, sb = b % 1024, swz = sb ^ (((sb >> 9) & 1) << 5); R = (st >> 1) * 16 + swz / 64; C = (st & 1) * 32 + (swz % 64) / 2; }
__host__ __device__ __forceinline__ int perm32(int rho) { const int n = rho >> 4, i = rho & 15; return 8 * (i >> 2) + 4 * n + (i & 3); }

struct Unit { int pm, pn; };
struct Gemm { const bf16_t* A; const bf16_t* Bt; int M, N, K; };

struct StaticOrder {
    int nM, nN, nwg, G, c;
    __host__ __device__ void init(int M, int N, int G_, int c_) { nM = M / BM; nN = N / BM; nwg = nM * nN; G = G_; c = c_; }
    __host__ __device__ bool next(int i, Unit& u) const {
        const long L = (long)i * G + c; if (L >= nwg) return false;
        int wgid = (int)L; { const int q = nwg / NXCD, r = nwg % NXCD, xcd = wgid % NXCD, off = wgid / NXCD; wgid = (xcd < r ? xcd * (q + 1) : r * (q + 1) + (xcd - r) * q) + off; }
        const int nig = WGM * nN, gid = wgid / nig, fm = gid * WGM, gsz = (nM - fm) < WGM ? (nM - fm) : WGM;
        u.pm = fm + ((wgid % nig) % gsz); u.pn = (wgid % nig) / gsz; return true;
    }
    __device__ __forceinline__ void a_ready(const Unit&) const {}
    __device__ __forceinline__ void done(const Unit&) const {}
};

__device__ __forceinline__ unsigned cvt_pk_bf16(float lo, float hi) { unsigned r; asm volatile("v_cvt_pk_bf16_f32 %0, %1, %2" : "=v"(r) : "v"(lo), "v"(hi)); return r; }
typedef float f32x2 __attribute__((ext_vector_type(2)));
typedef unsigned u32x2w __attribute__((ext_vector_type(2)));
__device__ __forceinline__ __amdgpu_buffer_rsrc_t wt_rsrc(const void* base, unsigned bytes) { return __builtin_amdgcn_make_buffer_rsrc((void*)base, 0, (int)bytes, 0x00020000); }
__device__ __forceinline__ void wt_store16(__amdgpu_buffer_rsrc_t rs, unsigned byte_off, u32x4 v) { __builtin_amdgcn_raw_buffer_store_b128(v, rs, byte_off, 0, 16); }
__device__ __forceinline__ void wt_store8(__amdgpu_buffer_rsrc_t rs, unsigned byte_off, u32x2w v) { __builtin_amdgcn_raw_buffer_store_b64(v, rs, byte_off, 0, 16); }
__device__ __forceinline__ float rstd_of(const float* SS, int row) { const f32x4 s = *(const f32x4*)(SS + (size_t)row * 4); return __builtin_amdgcn_rsqf(((s[0] + s[1]) + (s[2] + s[3])) * (1.0f / 1024.0f) + 1e-6f); }
__device__ __forceinline__ float silu_mul(float g, float u) { return g * u * __builtin_amdgcn_rcpf(1.0f + __builtin_amdgcn_exp2f(-1.4426950408889634f * g)); }
struct EpiGU {
    static constexpr bool PERM = true, AFTER_DRAIN = false;
    bf16_t* H; int ldh; const float* SS;
    __device__ __forceinline__ void operator()(const f32x4 (&acc)[2][2][4][2], const Unit& u, int wr, int wc, int fr, int fq, int wid, int lane, bool tailu) const {
        const int row0 = u.pm * BM + wr * 64 + fr, col0 = u.pn * HALF + wc * 32 + 8 * fq;
        const __amdgpu_buffer_rsrc_t rs = wt_rsrc(H, 16384u * 2816u * 2u);
        float rs_[2][4];
#pragma unroll
        for (int ai = 0; ai < 2; ++ai)
#pragma unroll
            for (int m = 0; m < 4; ++m) rs_[ai][m] = rstd_of(SS, row0 + ai * HALF + m * 16);
#pragma unroll
        for (int ai = 0; ai < 2; ++ai)
#pragma unroll
            for (int m = 0; m < 4; ++m) { const float r = rs_[ai][m]; const f32x4 g0 = acc[ai][0][m][0] * r, g1 = acc[ai][0][m][1] * r, u0 = acc[ai][1][m][0] * r, u1 = acc[ai][1][m][1] * r;
                u32x4 w; w.x = cvt_pk_bf16(silu_mul(g0[0], u0[0]), silu_mul(g0[1], u0[1])); w.y = cvt_pk_bf16(silu_mul(g0[2], u0[2]), silu_mul(g0[3], u0[3]));
                w.z = cvt_pk_bf16(silu_mul(g1[0], u1[0]), silu_mul(g1[1], u1[1])); w.w = cvt_pk_bf16(silu_mul(g1[2], u1[2]), silu_mul(g1[3], u1[3]));
                const unsigned bo = (unsigned)(((row0 + ai * HALF + m * 16) * ldh + col0) * 2); if (tailu) wt_store16(rs, bo, w); else *(u32x4*)((char*)H + bo) = w; }
    }
};
struct EpiQKV {
    static constexpr bool PERM = true, AFTER_DRAIN = false;
    bf16_t* O; int ldc; const float* SS;
    __device__ __forceinline__ void operator()(const f32x4 (&acc)[2][2][4][2], const Unit& u, int wr, int wc, int fr, int fq, int wid, int lane, bool tailu) const {
        const int row0 = u.pm * BM + wr * 64 + fr, col0 = u.pn * BM + wc * 32 + 8 * fq;
        const __amdgpu_buffer_rsrc_t ob = wt_rsrc(O, 16384u * 3072u * 2u);
        float rs[2][4];
#pragma unroll
        for (int ai = 0; ai < 2; ++ai)
#pragma unroll
            for (int m = 0; m < 4; ++m) rs[ai][m] = rstd_of(SS, row0 + ai * HALF + m * 16);
#pragma unroll
        for (int ai = 0; ai < 2; ++ai)
#pragma unroll
            for (int m = 0; m < 4; ++m) { const float r = rs[ai][m]; const unsigned rowb = (unsigned)(((row0 + ai * HALF + m * 16) * ldc + col0) * 2);
#pragma unroll
                for (int bj = 0; bj < 2; ++bj) { const f32x4 v0 = acc[ai][bj][m][0] * r, v1 = acc[ai][bj][m][1] * r;
                    u32x4 w; w.x = cvt_pk_bf16(v0[0], v0[1]); w.y = cvt_pk_bf16(v0[2], v0[3]); w.z = cvt_pk_bf16(v1[0], v1[1]); w.w = cvt_pk_bf16(v1[2], v1[3]);
                    if (tailu) wt_store16(ob, rowb + bj * HALF * 2, w); else *(u32x4*)((char*)O + rowb + bj * HALF * 2) = w; } }
    }
};
struct EpiRes {
    static constexpr bool PERM = false, AFTER_DRAIN = false;
    const float* Xin; float* X; bf16_t* XB; float* SS; float alpha; PG8_LAS float* P;
    __device__ __forceinline__ void operator()(const f32x4 (&acc)[2][2][4][2], const Unit& u, int wr, int wc, int fr, int fq, int wid, int lane, bool tailu) const {
        typedef unsigned u32x2v __attribute__((ext_vector_type(2)));
        const int col0 = u.pn * BM + wc * 32 + 4 * fq;
#pragma unroll
        for (int ai = 0; ai < 2; ++ai)
#pragma unroll
            for (int m = 0; m < 4; ++m) { const int r = ai * HALF + wr * 64 + m * 16 + fr; const size_t off = (size_t)(u.pm * BM + r) * 1024 + col0; float ss = 0.f;
#pragma unroll
                for (int bj = 0; bj < 2; ++bj)
#pragma unroll
                    for (int n = 0; n < 2; ++n) { const size_t o2 = off + bj * HALF + n * 16; const f32x4 xi = *(const f32x4*)(Xin + o2); const f32x4 xo = xi + acc[ai][bj][m][n] * alpha;
                        *(f32x4*)(X + o2) = xo; u32x2v w; w.x = cvt_pk_bf16(xo[0], xo[1]); w.y = cvt_pk_bf16(xo[2], xo[3]); *(u32x2v*)(XB + o2) = w;
                        ss += (xo[0] * xo[0] + xo[1] * xo[1]) + (xo[2] * xo[2] + xo[3] * xo[3]); }
                ss += __shfl_xor(ss, 16); ss += __shfl_xor(ss, 32);
                if (fq == 0) P[r * 4 + wc] = ss;
                if (m & 1) asm volatile("" ::: "memory"); }
        asm volatile("s_waitcnt lgkmcnt(0)" ::: "memory"); __builtin_amdgcn_s_barrier(); asm volatile("" ::: "memory");
        if (wc == 0 && fq == 0) {
#pragma unroll
            for (int ai = 0; ai < 2; ++ai)
#pragma unroll
                for (int m = 0; m < 4; ++m) { const int r = ai * HALF + wr * 64 + m * 16 + fr; const f32x4 p = *(const PG8_LAS f32x4*)(P + r * 4);
                    SS[(size_t)(u.pm * BM + r) * 4 + u.pn] = (p[0] + p[1]) + (p[2] + p[3]); }
        }
    }
};
template <class Epi, class Sched, bool ALIGN_EPI = false, bool SP2 = false>
__device__ __forceinline__ void gemm_phase(PG8_LAS unsigned char* lds, const Gemm g, const Sched& S, const Epi& E) {
    int tid_ = threadIdx.x; asm volatile("" : "+v"(tid_));
    const int tid = tid_, wid = __builtin_amdgcn_readfirstlane(tid >> 6), lane = tid & 63, wr = wid >> 2, wc = wid & 3, fr = lane & 15, fq = lane >> 4;
    const int K = g.K, nt = K / BK;
    unsigned voffA[2], voffB[2];
#pragma unroll
    for (int i = 0; i < 2; ++i) { int R, C; stage_rc(tid * 16 + i * 8192, R, C); const int Rb = Epi::PERM ? ((R & ~31) + perm32(R & 31)) : R;
        voffA[i] = (unsigned)(R * K + C) * 2u; voffB[i] = (unsigned)(Rb * K + C) * 2u; }
    const size_t kstep = (size_t)(BK * 2);
    const size_t hstep = (size_t)HALF * K * 2;
    const size_t tstep = 2 * hstep;
    const unsigned ldsw = (unsigned)wid * 1024u;
    const int aoff = lds_byte(wr * 64 + fr, fq * 8), boff = lds_byte(wc * 32 + fr, fq * 8);
#define PG8_SA(b, h) (((b) * 2 + (h)) * HTB)
#define PG8_SB(b, h) ((4 + (b) * 2 + (h)) * HTB)
#define PG8_STAGE(bufoff, gbase, voff) do { _Pragma("unroll") for (int _i = 0; _i < 2; ++_i) \
        __builtin_amdgcn_global_load_lds((const unsigned*)((const char*)(gbase) + (voff)[_i]), (PG8_LAS unsigned*)(lds + (bufoff) + ldsw + _i * 8192), 16, 0, 0); } while (0)
#define PG8_LDA(dst, b, h) do { _Pragma("unroll") for (int m = 0; m < 4; ++m) _Pragma("unroll") for (int k = 0; k < 2; ++k) dst[m][k] = *(const PG8_LAS bf16x8*)(lds + PG8_SA(b, h) + aoff + m * 2048 + k * 1024); } while (0)
#define PG8_LDB(dst, b, h) do { _Pragma("unroll") for (int n = 0; n < 2; ++n) _Pragma("unroll") for (int k = 0; k < 2; ++k) dst[n][k] = *(const PG8_LAS bf16x8*)(lds + PG8_SB(b, h) + boff + n * 2048 + k * 1024); } while (0)
#define PG8_MMA(ai, bj, At, Bt) do { __builtin_amdgcn_s_setprio(1); _Pragma("unroll") for (int m = 0; m < 4; ++m) _Pragma("unroll") for (int n = 0; n < 2; ++n) _Pragma("unroll") for (int k = 0; k < 2; ++k) \
        acc[ai][bj][m][n] = __builtin_amdgcn_mfma_f32_16x16x32_bf16(Bt[n][k], At[m][k], acc[ai][bj][m][n], 0, 0, 0); __builtin_amdgcn_s_setprio(0); } while (0)
#define PG8_WAIT_V(n) asm volatile("s_waitcnt vmcnt(" #n ")" ::: "memory")
#define PG8_WAIT_L(n) asm volatile("s_waitcnt lgkmcnt(" #n ")" ::: "memory")
#define PG8_BAR __builtin_amdgcn_s_barrier()
#define PG8_SCHED __builtin_amdgcn_sched_barrier(0)
    Unit cur, nxt; int ui = 0;
    if (!S.next(0, cur)) return;
    f32x4 acc[2][2][4][2];
#pragma unroll
    for (int a = 0; a < 2; ++a)
#pragma unroll
        for (int b = 0; b < 2; ++b)
#pragma unroll
            for (int m = 0; m < 4; ++m)
#pragma unroll
                for (int n = 0; n < 2; ++n) acc[a][b][m][n] = (f32x4){0.f, 0.f, 0.f, 0.f};
    bf16x8 At[4][2], B0[2][2], B1[2][2];
    const char* cA = (const char*)g.A + (size_t)cur.pm * tstep; const char* cB = (const char*)g.Bt + (size_t)cur.pn * tstep;
    S.a_ready(cur);
    if constexpr (SP2) {
        PG8_STAGE(PG8_SB(0, 0), cB, voffB); PG8_STAGE(PG8_SB(0, 1), cB + hstep, voffB); PG8_STAGE(PG8_SA(0, 0), cA, voffA); PG8_STAGE(PG8_SA(0, 1), cA + hstep, voffA);
        if (wr == 1) PG8_BAR;
        PG8_WAIT_V(2); PG8_BAR;
        PG8_STAGE(PG8_SB(1, 0), cB + kstep, voffB); PG8_STAGE(PG8_SA(1, 0), cA + kstep, voffA); PG8_STAGE(PG8_SB(1, 1), cB + hstep + kstep, voffB);
        PG8_WAIT_V(6); PG8_BAR;
    } else {
        PG8_STAGE(PG8_SB(0, 0), cB, voffB); PG8_STAGE(PG8_SA(0, 0), cA, voffA); PG8_STAGE(PG8_SB(0, 1), cB + hstep, voffB); PG8_STAGE(PG8_SA(0, 1), cA + hstep, voffA);
        if (wr == 1) PG8_BAR;
        PG8_WAIT_V(4); PG8_BAR;
        PG8_STAGE(PG8_SB(1, 0), cB + kstep, voffB); PG8_STAGE(PG8_SA(1, 0), cA + kstep, voffA); PG8_STAGE(PG8_SB(1, 1), cB + hstep + kstep, voffB);
        PG8_WAIT_V(6); PG8_BAR;
    }
    for (;;) {
        const bool has_next = S.next(ui + 1, nxt);
        const char* nA = has_next ? (const char*)g.A + (size_t)nxt.pm * tstep : cA; const char* nB = has_next ? (const char*)g.Bt + (size_t)nxt.pn * tstep : cB;
        for (int t = 0; t < nt; t += 2) {
            const bool last = (t == nt - 2);
            const char* a1 = cA + (size_t)(t + 1) * kstep;
            const char* a2 = last ? nA : cA + (size_t)(t + 2) * kstep; const char* b2 = last ? nB : cB + (size_t)(t + 2) * kstep;
            const char* a3 = a2 + kstep; const char* b3 = b2 + kstep;
            if (last && has_next) S.a_ready(nxt);
            if constexpr (SP2) {
            PG8_LDB(B0, 0, 0); PG8_LDB(B1, 0, 1); PG8_SCHED; PG8_LDA(At, 0, 0); PG8_STAGE(PG8_SA(1, 1), a1 + hstep, voffA);
            PG8_WAIT_V(8); PG8_WAIT_L(0); PG8_BAR; PG8_MMA(0, 0, At, B0); PG8_MMA(0, 1, At, B1); PG8_BAR; PG8_SCHED;
            PG8_LDA(At, 0, 1); PG8_STAGE(PG8_SB(0, 0), b2, voffB); PG8_STAGE(PG8_SB(0, 1), b2 + hstep, voffB); PG8_STAGE(PG8_SA(0, 0), a2, voffA);
            PG8_WAIT_V(8); PG8_WAIT_L(0); PG8_BAR; PG8_MMA(1, 0, At, B0); PG8_MMA(1, 1, At, B1); PG8_BAR; PG8_SCHED;
            PG8_LDB(B0, 1, 0); PG8_LDB(B1, 1, 1); PG8_SCHED; PG8_LDA(At, 1, 0); PG8_STAGE(PG8_SA(0, 1), a2 + hstep, voffA);
            PG8_WAIT_V(8); PG8_WAIT_L(0); PG8_BAR; PG8_MMA(0, 0, At, B0); PG8_MMA(0, 1, At, B1); PG8_BAR; PG8_SCHED;
            PG8_LDA(At, 1, 1); PG8_STAGE(PG8_SB(1, 0), b3, voffB); PG8_STAGE(PG8_SB(1, 1), b3 + hstep, voffB); PG8_STAGE(PG8_SA(1, 0), a3, voffA);
            PG8_WAIT_V(8); PG8_WAIT_L(0); PG8_BAR; PG8_MMA(1, 0, At, B0); PG8_MMA(1, 1, At, B1); PG8_BAR; PG8_SCHED;
            } else {
            PG8_LDB(B0, 0, 0); PG8_SCHED; PG8_LDA(At, 0, 0); PG8_STAGE(PG8_SA(1, 1), a1 + hstep, voffA);
            PG8_WAIT_L(8); PG8_BAR; PG8_WAIT_L(0); PG8_MMA(0, 0, At, B0); PG8_BAR; PG8_SCHED;
            PG8_LDB(B1, 0, 1); PG8_STAGE(PG8_SB(0, 0), b2, voffB);
            PG8_BAR; PG8_WAIT_L(0); PG8_MMA(0, 1, At, B1); PG8_BAR;
            PG8_LDA(At, 0, 1); PG8_STAGE(PG8_SA(0, 0), a2, voffA);
            PG8_BAR; PG8_WAIT_L(0); PG8_MMA(1, 0, At, B0); PG8_BAR; PG8_SCHED;
            PG8_STAGE(PG8_SB(0, 1), b2 + hstep, voffB);
            PG8_WAIT_V(6); PG8_BAR; PG8_MMA(1, 1, At, B1); PG8_BAR;
            PG8_LDB(B0, 1, 0); PG8_SCHED; PG8_LDA(At, 1, 0); PG8_STAGE(PG8_SA(0, 1), a2 + hstep, voffA);
            PG8_WAIT_L(8); PG8_BAR; PG8_WAIT_L(0); PG8_MMA(0, 0, At, B0); PG8_BAR; PG8_SCHED;
            PG8_LDB(B1, 1, 1); PG8_STAGE(PG8_SB(1, 0), b3, voffB);
            PG8_BAR; PG8_WAIT_L(0); PG8_MMA(0, 1, At, B1); PG8_BAR;
            PG8_LDA(At, 1, 1); PG8_STAGE(PG8_SA(1, 0), a3, voffA);
            PG8_BAR; PG8_WAIT_L(0); PG8_MMA(1, 0, At, B0); PG8_BAR; PG8_SCHED;
            PG8_STAGE(PG8_SB(1, 1), b3 + hstep, voffB);
            PG8_WAIT_V(6); PG8_BAR; PG8_MMA(1, 1, At, B1); PG8_BAR;
            }
        }
        if constexpr (ALIGN_EPI) { if (wr == 0) PG8_BAR; }
        if constexpr (!Epi::AFTER_DRAIN) { Unit u2_; const bool tailu = !S.next(ui + 2, u2_);
            E(acc, cur, wr, wc, fr, fq, wid, lane, tailu); S.done(cur); }
        if (!has_next) break;
#pragma unroll
        for (int a = 0; a < 2; ++a)
#pragma unroll
            for (int b = 0; b < 2; ++b)
#pragma unroll
                for (int m = 0; m < 4; ++m)
#pragma unroll
                    for (int n = 0; n < 2; ++n) acc[a][b][m][n] = (f32x4){0.f, 0.f, 0.f, 0.f};
        cur = nxt; cA = nA; cB = nB; ++ui;
        if constexpr (ALIGN_EPI) { if (wr == 1) PG8_BAR; }
    }
    PG8_WAIT_V(0);
    if constexpr (!ALIGN_EPI) { if (wr == 0) PG8_BAR; }
    PG8_BAR;
    if constexpr (Epi::AFTER_DRAIN) { E.fused(acc, cur, wr, wc, fr, fq, lds, wid, lane); S.done(cur); }
#undef PG8_SA
#undef PG8_SB
#undef PG8_STAGE
#undef PG8_LDA
#undef PG8_LDB
#undef PG8_MMA
#undef PG8_WAIT_V
#undef PG8_WAIT_L
#undef PG8_BAR
#undef PG8_SCHED
}
}
#include <hip/hip_bf16.h>
namespace attn_body {
using bf16=__hip_bfloat16;
using bf16x8=__attribute__((ext_vector_type(8)))short;
using s16x4=__attribute__((ext_vector_type(4)))short;
using f32x16=__attribute__((ext_vector_type(16)))float;
using f32x4v=__attribute__((ext_vector_type(4)))float;
using u32x4=__attribute__((ext_vector_type(4)))unsigned;
constexpr int SEQ=4096,PQ=3072,PO=1024;
constexpr int NW=8,QBLK=32,QB=QBLK*NW,KVBLK=64;
__device__ __forceinline__ int crow(int r,int hi){return (r&3)+8*(r>>2)+4*hi;}
#define SBAR() __builtin_amdgcn_sched_barrier(0)
__device__ __forceinline__ void cmask(f32x16&p0,f32x16&p1,int jb,int qrel,int hi){
  const float NEG=-INFINITY; int kb=64*jb+4*hi;
  #pragma unroll
  for(int r=0;r<16;++r){int kv=kb+(r&3)+8*(r>>2); if(kv>qrel)p0[r]=NEG; if(kv+32>qrel)p1[r]=NEG;}
}
constexpr int NSLOT=3, SLOTB=8192;
constexpr int DTOP=2176, TB_NI=DTOP+320, TB_STRIDE=TB_NI*4+16;
template<int VD> struct Lay {
  static constexpr int VSLOT=SLOTB*(VD/64), LDS_K=0, LDS_V=NSLOT*SLOTB, LDS_WS=LDS_V+NSLOT*VSLOT, LDS_OST=LDS_WS+NW*64*4, LDS_TB=LDS_OST+NW*4096, LDS_BYTES=LDS_TB+4*TB_STRIDE;
};
__device__ __forceinline__ void glds16(const void*gsrc,unsigned lds_dst){unsigned keep;
  asm volatile("s_mov_b32 %0, m0\n\ts_mov_b32 m0, %2\n\ts_nop 0\n\tglobal_load_lds_dwordx4 %1, off\n\ts_mov_b32 m0, %0":"=&s"(keep):"v"(gsrc),"s"(lds_dst):"memory");}
__device__ __forceinline__ float fsub_s(float a,float b){float r;asm("v_sub_f32_e32 %0, %1, %2":"=v"(r):"v"(a),"v"(b));return r;}
typedef float f32x2_t __attribute__((ext_vector_type(2))); typedef __bf16 bf16x2_t __attribute__((ext_vector_type(2)));
__device__ __forceinline__ unsigned cvtpk_s(float lo,float hi){f32x2_t v={lo,hi};bf16x2_t b=__builtin_convertvector(v,bf16x2_t);return __builtin_bit_cast(unsigned,b);}
#define WAIT_BAR(N) asm volatile("s_waitcnt vmcnt(" #N ") lgkmcnt(0)\n\ts_barrier":::"memory")
typedef __attribute__((address_space(3))) const char* lds_cptr;
typedef short v4i16_t __attribute__((ext_vector_type(4)));
__device__ __forceinline__ void kload8(bf16x8*kf,lds_cptr kp){
  kf[0]=*(const __attribute__((address_space(3))) bf16x8*)(kp);      kf[1]=*(const __attribute__((address_space(3))) bf16x8*)(kp+512);
  kf[2]=*(const __attribute__((address_space(3))) bf16x8*)(kp+2048); kf[3]=*(const __attribute__((address_space(3))) bf16x8*)(kp+2560);
  kf[4]=*(const __attribute__((address_space(3))) bf16x8*)(kp+4096); kf[5]=*(const __attribute__((address_space(3))) bf16x8*)(kp+4608);
  kf[6]=*(const __attribute__((address_space(3))) bf16x8*)(kp+6144); kf[7]=*(const __attribute__((address_space(3))) bf16x8*)(kp+6656);
}
__device__ __forceinline__ void kload2(bf16x8*kf,lds_cptr kp,int j){ kf[2*j]=*(const __attribute__((address_space(3))) bf16x8*)(kp+j*2048); kf[2*j+1]=*(const __attribute__((address_space(3))) bf16x8*)(kp+j*2048+512); }
__device__ __forceinline__ s16x4 vtr(lds_cptr p){ return __builtin_bit_cast(s16x4,__builtin_amdgcn_ds_read_tr16_b64_v4i16((__attribute__((address_space(3))) v4i16_t*)p)); }
__device__ __forceinline__ void bload2(f32x16&c,lds_cptr bp,int off,int g){ const f32x4v v=*(const __attribute__((address_space(3))) f32x4v*)(bp+off+32*g); c[4*g]=v[0];c[4*g+1]=v[1];c[4*g+2]=v[2];c[4*g+3]=v[3]; }
__device__ __forceinline__ void bload16(f32x16&c0,f32x16&c1,lds_cptr bp){
  #pragma unroll
  for(int g=0;g<4;++g){bload2(c0,bp,0,g);bload2(c1,bp,128,g);} }
#define MX3(a,b,c) __builtin_fmaxf(__builtin_fmaxf((a),(b)),(c))
__device__ __forceinline__ float rowmax(const f32x16&p0,const f32x16&p1){
  float a=MX3(p0[0],p0[1],p1[0]),b=MX3(p0[2],p0[3],p1[1]);a=MX3(a,p1[2],p1[3]);
  #pragma unroll
  for(int r=4;r<16;r+=4){a=MX3(a,p0[r],p0[r+1]);b=MX3(b,p0[r+2],p0[r+3]);a=MX3(a,p1[r],p1[r+1]);b=MX3(b,p1[r+2],p1[r+3]);}
  float m=__builtin_fmaxf(a,b);
  auto rr=__builtin_amdgcn_permlane32_swap(__float_as_uint(m),__float_as_uint(m),false,false);
  return __builtin_fmaxf(__uint_as_float(rr[0]),__uint_as_float(rr[1]));
}
template<int ND> __device__ __forceinline__ void pv(f32x16*o,int vb,bf16x8 pa0,bf16x8 pa1,bf16x8 pa2,bf16x8 pa3){
  #pragma unroll
  for(int d0=0;d0<ND;++d0){s16x4 lo[4],hi[4];
    #pragma unroll
    for(int ks=0;ks<4;++ks){
      asm volatile("ds_read_b64_tr_b16 %0,%1 offset:%c2":"=&v"(lo[ks]):"v"(vb),"i"(d0*4096+ks*1024):"memory");
      asm volatile("ds_read_b64_tr_b16 %0,%1 offset:%c2":"=&v"(hi[ks]):"v"(vb),"i"(d0*4096+ks*1024+512):"memory");}
    asm volatile("s_waitcnt lgkmcnt(0)":::"memory");SBAR();
    #define PK(k) (bf16x8){lo[k][0],lo[k][1],lo[k][2],lo[k][3],hi[k][0],hi[k][1],hi[k][2],hi[k][3]}
    o[d0]=__builtin_amdgcn_mfma_f32_32x32x16_bf16(pa0,PK(0),o[d0],0,0,0);
    o[d0]=__builtin_amdgcn_mfma_f32_32x32x16_bf16(pa1,PK(1),o[d0],0,0,0);
    o[d0]=__builtin_amdgcn_mfma_f32_32x32x16_bf16(pa2,PK(2),o[d0],0,0,0);
    o[d0]=__builtin_amdgcn_mfma_f32_32x32x16_bf16(pa3,PK(3),o[d0],0,0,0);
    #undef PK
  }
}
struct AttnUnit { int qcol,kcol,vcol,ocol,c,b,qb,T0; bf16* O; };
template<int VD> __device__ __forceinline__ void build_bias(char*shm,const float*BT,int c){
  float*tb=(float*)(shm+Lay<VD>::LDS_TB); const float*bt=BT+c*4096;
  for(int e=threadIdx.x;e<4*TB_NI;e+=NW*64){ const int s=e/TB_NI,i=e-s*TB_NI,d=DTOP-i-s; tb[s*(TB_STRIDE/4)+i]=d>=0?bt[d]:0.f; }
}
template<int N> __device__ __forceinline__ void wait_bar(){ asm volatile("s_waitcnt vmcnt(%0) lgkmcnt(0)\n\ts_barrier"::"n"(N):"memory"); }
template<int VD,int THRL> __device__ __forceinline__ void attn_unit(const AttnUnit&u,const bf16*QKV,char*shm,unsigned*qhead,unsigned&ticket){
  using L=Lay<VD>; constexpr int ND=VD/32, VM=VD/64;
  #define WB(kc,vc) wait_bar<(kc)+(vc)*VM>()
  int tid_=threadIdx.x; asm volatile("":"+v"(tid_));
  const int tid=tid_,lane=tid&63,r32=lane&31,hi=lane>>5; const int wid=__builtin_amdgcn_readfirstlane(tid>>6);
  const long rowbase=(long)u.b*SEQ; const int q0=u.qb*QB;
  const bf16*Qw=QKV+(rowbase+q0+wid*QBLK)*PQ+u.qcol;
  const bf16*Kh=QKV+(rowbase+(long)u.T0*KVBLK)*PQ+u.kcol,*Vh=QKV+(rowbase+(long)u.T0*KVBLK)*PQ+u.vcol;
  const unsigned lds0=(unsigned)(uintptr_t)shm;
  float*wsf=(float*)(shm+L::LDS_WS)+wid*64;
  const bf16*ksrc=Kh+(long)lane*PQ+wid*8;
  const bf16*vsrc=Vh+(long)(16*(wid&3)+(lane>>2))*PQ+(wid>>2)*32+(lane&3)*8;
  const unsigned kdst=lds0+L::LDS_K+wid*1024, vdst=lds0+L::LDS_V+wid*1024;
  #define DMA_K(t,slot) glds16(ksrc+(long)(t)*KVBLK*PQ,(unsigned)__builtin_amdgcn_readfirstlane(kdst+(slot)))
  #define DMA_V(t,slot) do{ _Pragma("unroll") for(int i_=0;i_<VM;++i_) glds16(vsrc+(long)(t)*KVBLK*PQ+64*i_,(unsigned)__builtin_amdgcn_readfirstlane(vdst+(slot)*VM+8192*i_)); }while(0)
  const int vb0=(int)(lds0+L::LDS_V)+((lane>>4)&1)*32+(lane&3)*8+(4*hi+((lane&15)>>2))*64;
  bf16x8 kf[8];
  const lds_cptr shm3=(lds_cptr)shm; const lds_cptr kp0=shm3+L::LDS_K+hi*1024+r32*16; const lds_cptr vp0=shm3+L::LDS_V+((lane>>4)&1)*32+(lane&3)*8+(4*hi+((lane&15)>>2))*64;
  const int NT=(q0+QB)/KVBLK-u.T0;
  const int sft=(4-(r32&3))&3; const lds_cptr tbs=shm3+L::LDS_TB+sft*TB_STRIDE;
  int bnext=DTOP-(q0+wid*QBLK+r32)+KVBLK*u.T0+4*hi-sft;
  #define BPTR() (tbs+4*(bnext>0?bnext:0))
  DMA_K(0,0);DMA_V(0,0);DMA_K(1,SLOTB);
  bf16x8 qr[4];
  #pragma unroll
  for(int d0=0;d0<4;++d0)qr[d0]=*reinterpret_cast<const bf16x8*>(&Qw[(long)r32*PQ+d0*16+hi*8]);
  const lds_cptr qlp=shm3+L::LDS_OST+wid*4096+lane*16; bf16x8 qx=qr[0],qy=qr[1];
  if constexpr(VD==128){
    #pragma unroll
    for(int d0=0;d0<4;++d0)*(__attribute__((address_space(3))) bf16x8*)(shm3+L::LDS_OST+wid*4096+lane*16+d0*1024)=qr[d0]; }
  #define QF(d0) (VD==128?(((d0)&1)?qy:qx):qr[d0])
  #define QLD(d0) do{ if constexpr(VD==128){ (((d0)&1)?qy:qx)=*(const __attribute__((address_space(3))) bf16x8*)(qlp+(d0)*1024); SBAR(); } }while(0)
  float mhat=0.f,l_reg=0.f;f32x16 o[ND];
  #pragma unroll
  for(int d_=0;d_<ND;++d_)o[d_]=f32x16{};
  const int qrel=wid*QBLK+r32;
  #define CMASK(P0,P1,t) do{int jb_=(t)-(NT-4); if(jb_>=0)cmask(P0,P1,jb_,qrel,hi);}while(0)
  bool resc=false;
  #define RESC() do{ if(resc){ asm volatile("s_waitcnt lgkmcnt(0)":::"memory"); \
      _Pragma("unroll") for(int d_=0;d_<ND;++d_) _Pragma("unroll") for(int r=0;r<16;++r)o[d_][r]*=wsf[crow(r,hi)]; } }while(0)
  f32x16 pA0,pA1,pB0,pB1;
  int sl_prev=0,sl_cur=0,sl_next=SLOTB;
  #define ROT() do{sl_prev=sl_cur;sl_cur=sl_next;sl_next=(sl_next==(NSLOT-1)*SLOTB)?0:sl_next+SLOTB;}while(0)
  DMA_K(2,2*SLOTB);
  WB(2,1);
  bload16(pA0,pA1,BPTR()); bnext+=KVBLK;
  { const char*kb=shm+L::LDS_K+hi*1024+r32*16;
    #pragma unroll
    for(int d0=0;d0<4;++d0){ const bf16x8 b0=*reinterpret_cast<const bf16x8*>(kb+d0*2048); const bf16x8 b1=*reinterpret_cast<const bf16x8*>(kb+d0*2048+512);
      pA0=__builtin_amdgcn_mfma_f32_32x32x16_bf16(b0,qr[d0],pA0,0,0,0); pA1=__builtin_amdgcn_mfma_f32_32x32x16_bf16(b1,qr[d0],pA1,0,0,0);} }
  asm volatile("s_nop 15\n\ts_nop 7":"+v"(pA0),"+v"(pA1));CMASK(pA0,pA1,0);
  { const float rm=rowmax(pA0,pA1); mhat=__builtin_fmaxf(rm,-1e30f);
    _Pragma("unroll") for(int r=0;r<16;++r){pA0[r]=__builtin_amdgcn_exp2f(fsub_s(pA0[r],mhat));}
    _Pragma("unroll") for(int r=0;r<16;++r){pA1[r]=__builtin_amdgcn_exp2f(fsub_s(pA1[r],mhat));} }
  WB(0,0);
  DMA_K(3,0);DMA_V(1,SLOTB);
  ROT();
  kload8(kf,kp0+sl_cur);
  bload16(pB0,pB1,BPTR()); bnext+=KVBLK;
  WB(1,1);
  s16x4 vlo[8],vhi[8]; u32x4 pw0,pw1,pw2,pw3;
  #define PKW(P,B) cvtpk_s(P[B],P[B+1])
  #define PAF(k) __builtin_bit_cast(bf16x8,pw##k)
  #define VFR(i) (bf16x8){vlo[i][0],vlo[i][1],vlo[i][2],vlo[i][3],vhi[i][0],vhi[i][1],vhi[i][2],vhi[i][3]}
  #define PIN(x) asm volatile("":"+v"(x))
  #define GAPA(MF,A0,A1,A2,A3,W0,W1,PW) do{ MF; sacc+=A0; sacc+=A1; sacc+=A2; sacc+=A3; PIN(sacc); W0; W1; PIN(PW); SBAR(); }while(0)
  #define EX(v) __builtin_amdgcn_exp2f(fsub_s(v,mhat))
  #define GAPB(MF,X,B) do{ MF; X[B]=EX(X[B]); X[B+1]=EX(X[B+1]); X[B+2]=EX(X[B+2]); X[B+3]=EX(X[B+3]); PIN(X); SBAR(); }while(0)
  #define GAPB2(MF,X,B) do{ MF; X[B]=EX(X[B]); X[B+1]=EX(X[B+1]); PIN(X); SBAR(); }while(0)
  #define VRDF(sl,d0,ks) do{ vlo[sl]=vtr(vp_+((d0)*4096+(ks)*1024)); vhi[sl]=vtr(vp_+((d0)*4096+(ks)*1024+512)); }while(0)
  #define KRD(G,j) do{ if(G){ kload2(kf,kp0+sl_next,j); SBAR(); } }while(0)
  #define BRD(G,P,off,g) do{ if(G){ bload2(P,bp_,off,g); bload2(P,bp_,off,(g)+1); SBAR(); } }while(0)
  #define MF32(a,b,c) __builtin_amdgcn_mfma_f32_32x32x16_bf16(a,b,c,0,0,0)
  #define VA64(j) VRDF(((j)>>1)+4*((j)&1),(j)&1,(j)>>1)
  #define VA128(j) VRDF(j,(j)&3,(j)>>2)
  #define PHASE_A(C0,C1,P0,P1,VA) \
    VA(0); SBAR(); float sacc=(P0[0]+P0[1]); \
    QLD(1); GAPA(C0=MF32(kf[0],QF(0),C0), P0[2],P0[3],P0[4],P0[5],     pw0[0]=PKW(P0,0), pw0[1]=PKW(P0,2), pw0); \
    VA(1); SBAR(); GAPA(C1=MF32(kf[1],QF(0),C1), P0[6],P0[7],P0[8],P0[9],     pw0[2]=PKW(P0,4), pw0[3]=PKW(P0,6), pw0); \
    VA(2); SBAR(); QLD(2); GAPA(C0=MF32(kf[2],QF(1),C0), P0[10],P0[11],P0[12],P0[13], pw1[0]=PKW(P0,8), pw1[1]=PKW(P0,10), pw1); \
    VA(3); SBAR(); GAPA(C1=MF32(kf[3],QF(1),C1), P0[14],P0[15],P1[0],P1[1],   pw1[2]=PKW(P0,12),pw1[3]=PKW(P0,14), pw1); \
    VA(4); SBAR(); QLD(3); GAPA(C0=MF32(kf[4],QF(2),C0), P1[2],P1[3],P1[4],P1[5],     pw2[0]=PKW(P1,0), pw2[1]=PKW(P1,2), pw2); \
    VA(5); SBAR(); GAPA(C1=MF32(kf[5],QF(2),C1), P1[6],P1[7],P1[8],P1[9],     pw2[2]=PKW(P1,4), pw2[3]=PKW(P1,6), pw2); \
    VA(6); SBAR(); GAPA(C0=MF32(kf[6],QF(3),C0), P1[10],P1[11],P1[12],P1[13], pw3[0]=PKW(P1,8), pw3[1]=PKW(P1,10), pw3); \
    VA(7); SBAR(); GAPA(C1=MF32(kf[7],QF(3),C1), P1[14],P1[15],0.f,0.f,       pw3[2]=PKW(P1,12),pw3[3]=PKW(P1,14), pw3); \
    l_reg+=sacc;
  #define DECIDE(C0,C1,t,GK,GV) \
    if(GK){DMA_K((t)+3,sl_cur);} if(GV){DMA_V((t)+1,sl_next);} \
    CMASK(C0,C1,t); \
    { float a=MX3(C0[0],C0[1],C1[0]),b=MX3(C0[2],C0[3],C1[1]); a=MX3(a,C1[2],C1[3]); \
      _Pragma("unroll") for(int r=4;r<16;r+=4){a=MX3(a,C0[r],C0[r+1]);b=MX3(b,C0[r+2],C0[r+3]);a=MX3(a,C1[r],C1[r+1]);b=MX3(b,C1[r+2],C1[r+3]);} \
      float rm=__builtin_fmaxf(a,b); { auto rr=__builtin_amdgcn_permlane32_swap(__float_as_uint(rm),__float_as_uint(rm),false,false); rm=__builtin_fmaxf(__uint_as_float(rr[0]),__uint_as_float(rr[1])); } \
      resc=false; \
      if(__builtin_expect(__any(rm-mhat>(float)THRL),0)){ const float mn=__builtin_fmaxf(rm,mhat); const float f=__builtin_amdgcn_exp2f(mhat-mn); mhat=mn; \
        l_reg*=f; if(hi==0)wsf[r32]=f; resc=true; } } \
    SBAR();
  #define STEP(C0,C1,P0,P1,t,GK,GV,GL) do{ SBAR(); \
    const lds_cptr vp_=vp0+sl_prev*VM; const lds_cptr bp_=BPTR(); \
    if constexpr(VD==64){ \
      PHASE_A(C0,C1,P0,P1,VA64) \
      DECIDE(C0,C1,t,GK,GV) \
      GAPB(o[0]=MF32(PAF(0),VFR(0),o[0]), C0,0); \
      BRD(GL,P0,0,0); GAPB(o[1]=MF32(PAF(0),VFR(4),o[1]), C0,4); \
      KRD(GL,0); GAPB(o[0]=MF32(PAF(1),VFR(1),o[0]), C0,8); \
      KRD(GL,1); GAPB(o[1]=MF32(PAF(1),VFR(5),o[1]), C0,12); \
      KRD(GL,2); GAPB(o[0]=MF32(PAF(2),VFR(2),o[0]), C1,0); \
      KRD(GL,3); GAPB(o[1]=MF32(PAF(2),VFR(6),o[1]), C1,4); \
      BRD(GL,P0,0,2); GAPB(o[0]=MF32(PAF(3),VFR(3),o[0]), C1,8); \
      BRD(GL,P1,128,0); GAPB(o[1]=MF32(PAF(3),VFR(7),o[1]), C1,12); \
      BRD(GL,P1,128,2); \
    } else { \
      PHASE_A(C0,C1,P0,P1,VA128) \
      DECIDE(C0,C1,t,GK,GV) \
        \
      GAPB2(o[0]=MF32(PAF(0),VFR(0),o[0]), C0,0);  VRDF(0,0,2); SBAR(); \
      GAPB2(o[1]=MF32(PAF(0),VFR(1),o[1]), C0,2);  VRDF(1,1,2); SBAR(); \
      GAPB2(o[2]=MF32(PAF(0),VFR(2),o[2]), C0,4);  VRDF(2,2,2); SBAR(); \
      GAPB2(o[3]=MF32(PAF(0),VFR(3),o[3]), C0,6);  VRDF(3,3,2); SBAR(); \
      KRD(GL,0); GAPB2(o[0]=MF32(PAF(1),VFR(4),o[0]), C0,8);  VRDF(4,0,3); SBAR(); \
      KRD(GL,1); GAPB2(o[1]=MF32(PAF(1),VFR(5),o[1]), C0,10); VRDF(5,1,3); SBAR(); \
      KRD(GL,2); GAPB2(o[2]=MF32(PAF(1),VFR(6),o[2]), C0,12); VRDF(6,2,3); SBAR(); \
      KRD(GL,3); GAPB2(o[3]=MF32(PAF(1),VFR(7),o[3]), C0,14); VRDF(7,3,3); SBAR(); \
      BRD(GL,P0,0,0); GAPB2(o[0]=MF32(PAF(2),VFR(0),o[0]), C1,0); \
      BRD(GL,P0,0,2); GAPB2(o[1]=MF32(PAF(2),VFR(1),o[1]), C1,2); \
      BRD(GL,P1,128,0); GAPB2(o[2]=MF32(PAF(2),VFR(2),o[2]), C1,4); \
      BRD(GL,P1,128,2); GAPB2(o[3]=MF32(PAF(2),VFR(3),o[3]), C1,6); \
      GAPB2(o[0]=MF32(PAF(3),VFR(4),o[0]), C1,8); \
      GAPB2(o[1]=MF32(PAF(3),VFR(5),o[1]), C1,10); \
      GAPB2(o[2]=MF32(PAF(3),VFR(6),o[2]), C1,12); \
      QLD(0); GAPB2(o[3]=MF32(PAF(3),VFR(7),o[3]), C1,14); \
    } \
    bnext+=KVBLK; \
    }while(0)
  int t=1;
  #undef CMASK
  #define CMASK(P0,P1,t) do{}while(0)
  for(;t+5<NT;t+=2){
    STEP(pB0,pB1,pA0,pA1,t,true,true,true);     WB(1,1); RESC(); ROT();
    STEP(pA0,pA1,pB0,pB1,t+1,true,true,true);   WB(1,1); RESC(); ROT();
  }
  #undef CMASK
  #define CMASK(P0,P1,t) do{int jb_=(t)-(NT-4); if(jb_>=0)cmask(P0,P1,jb_,qrel,hi);}while(0)
  #define ENDW(tt) do{ if((tt)+3<NT){WB(1,1);} else if((tt)+2<NT){WB(0,1);} else {WB(0,0);} }while(0)
  for(;t+1<NT;t+=2){
    STEP(pB0,pB1,pA0,pA1,t,(t+3<NT),(t+1<NT),(t+1<NT));       ENDW(t);   RESC(); ROT();
    STEP(pA0,pA1,pB0,pB1,t+1,(t+4<NT),(t+2<NT),(t+2<NT));     ENDW(t+1); RESC(); ROT();
  }
  STEP(pB0,pB1,pA0,pA1,NT-1,false,false,false); RESC();
  if(tid==0)ticket=__hip_atomic_fetch_add(qhead,1u,__ATOMIC_RELAXED,__HIP_MEMORY_SCOPE_AGENT);
  { float sacc=pB0[0]+pB0[1]; _Pragma("unroll") for(int r=2;r<16;++r)sacc+=pB0[r]; _Pragma("unroll") for(int r=0;r<16;++r)sacc+=pB1[r]; l_reg+=sacc;
    pw0=(u32x4){PKW(pB0,0),PKW(pB0,2),PKW(pB0,4),PKW(pB0,6)};pw1=(u32x4){PKW(pB0,8),PKW(pB0,10),PKW(pB0,12),PKW(pB0,14)};pw2=(u32x4){PKW(pB1,0),PKW(pB1,2),PKW(pB1,4),PKW(pB1,6)};pw3=(u32x4){PKW(pB1,8),PKW(pB1,10),PKW(pB1,12),PKW(pB1,14)};
    SBAR(); pv<ND>(o,vb0+sl_cur*VM,PAF(0),PAF(1),PAF(2),PAF(3)); }
  {auto rr=__builtin_amdgcn_permlane32_swap(__float_as_uint(l_reg),__float_as_uint(l_reg),false,false);l_reg=__uint_as_float(rr[0])+__uint_as_float(rr[1]);}
  if(hi==0)wsf[32+r32]=l_reg;asm volatile("s_waitcnt lgkmcnt(0)":::"memory");
  float rli[16];
  #pragma unroll
  for(int r=0;r<16;++r)rli[r]=__builtin_amdgcn_rcpf(wsf[32+crow(r,hi)]);
  bf16*Ow=u.O+(rowbase+q0+wid*QBLK)*PO+u.ocol; const __amdgpu_buffer_rsrc_t orsrc=__builtin_amdgcn_make_buffer_rsrc((void*)Ow,0,QBLK*PO*2,0x00020000);
  { bf16*stg=(bf16*)(shm+L::LDS_OST)+wid*2048;
    #pragma unroll
    for(int p=0;p<VM;++p){
      #pragma unroll
      for(int r=0;r<16;++r){const int orow=crow(r,hi);
        #pragma unroll
        for(int d0=0;d0<2;++d0)stg[orow*64+d0*32+r32]=__float2bfloat16(o[2*p+d0][r]*rli[r]);}
      asm volatile("s_waitcnt lgkmcnt(0)":::"memory");
      #pragma unroll
      for(int i=0;i<4;++i){const int row=i*8+(lane>>3),ch=lane&7; const u32x4 v=*(const u32x4*)(stg+row*64+ch*8); __builtin_amdgcn_raw_buffer_store_b128(v,orsrc,(unsigned)((row*PO+p*64+ch*8)*2),0,16);}
      asm volatile("s_waitcnt lgkmcnt(0)":::"memory"); } }
  asm volatile("s_waitcnt lgkmcnt(0)\n\ts_barrier":::"memory");
  #undef PKW
  #undef PAF
  #undef VFR
  #undef PIN
  #undef GAPA
  #undef GAPB
  #undef GAPB2
  #undef EX
  #undef VRDF
  #undef KRD
  #undef BRD
  #undef MF32
  #undef PHASE_A
  #undef QF
  #undef QLD
  #undef VA64
  #undef VA128
  #undef DECIDE
  #undef STEP
  #undef ENDW
  #undef DMA_K
  #undef DMA_V
  #undef CMASK
  #undef RESC
  #undef ROT
  #undef BPTR
  #undef WB
}
constexpr int ATTN_LDS_BYTES=Lay<128>::LDS_BYTES;
#undef SBAR
#undef WAIT_BAR
#undef MX3
}
#define GAS __attribute__((address_space(1)))
#define LAS __attribute__((address_space(3)))
typedef unsigned short bf16;
typedef unsigned v4u __attribute__((ext_vector_type(4)));
typedef float f32x4 __attribute__((ext_vector_type(4)));
typedef short bf16x8 __attribute__((ext_vector_type(8)));
typedef GAS unsigned gu32;
typedef GAS unsigned long long gu64;
#define RLX_AGENT __ATOMIC_RELAXED, __HIP_MEMORY_SCOPE_AGENT
#define LDS_WAIT() asm volatile("s_waitcnt lgkmcnt(0)" ::: "memory")
#define VM_WAIT() asm volatile("s_waitcnt vmcnt(0)" ::: "memory")
__device__ __forceinline__ unsigned long long rt() { return __builtin_amdgcn_s_memrealtime(); }

#define XB_TMO      128
#define XB_XCNT(j)  (256  + 64 * (j))
#define XB_XSUB(j)  (1280 + 64 * (j))
#define XB_XGEN(j)  (2304 + 64 * (j))
#define XB_TOP      3328
#define XB_TOPGEN   3392
#define XCD_BAR_WORDS 3456
#define XB_SPIN_CAP (1u << 18)

__device__ __forceinline__ unsigned xb_ld(unsigned* p)              { return __hip_atomic_load(p, __ATOMIC_RELAXED, __HIP_MEMORY_SCOPE_AGENT); }
__device__ __forceinline__ unsigned xb_add(unsigned* p, unsigned v) { return __hip_atomic_fetch_add(p, v, __ATOMIC_RELAXED, __HIP_MEMORY_SCOPE_AGENT); }
__device__ __forceinline__ unsigned xb_xcc_id() { return (unsigned)__builtin_amdgcn_s_getreg((3 << 11) | 20) & 0xFu; }
#define XB_SPIN(cond, bar) do { unsigned _sp = 0; while (cond) { __builtin_amdgcn_s_sleep(1); \
    if ((++_sp & 255u) == 0u) { if (xb_ld(&(bar)[XB_TMO])) break; if (_sp > XB_SPIN_CAP) { atomicAdd(&(bar)[XB_TMO], 1u); break; } } } } while (0)

struct XcdBarrier {
    unsigned* bar; unsigned x;
    volatile LAS unsigned* st;
};

__device__ __forceinline__ XcdBarrier xcd_barrier_post(unsigned* bar, volatile LAS unsigned* st) {
    XcdBarrier b; b.bar = bar; b.x = xb_xcc_id(); b.st = st;
    if (threadIdx.x == 0) (void)xb_add(&bar[XB_XCNT(b.x)], 1u);
    return b;
}
__device__ __forceinline__ void xcd_barrier_complete(unsigned* bar, unsigned x, unsigned& nloc, unsigned& nx) {
    const unsigned G = gridDim.x * gridDim.y * gridDim.z;
    unsigned sum, cnt, mine, sp = 0u;
    for (;;) {
        sum = 0u; cnt = 0u; mine = 0u;
#pragma unroll
        for (unsigned j = 0; j < 16; ++j) { const unsigned c = xb_ld(&bar[XB_XCNT(j)]); sum += c; cnt += (c > 0u) ? 1u : 0u; mine = (j == x) ? c : mine; }
        if (sum == G) break;
        __builtin_amdgcn_s_sleep(1);
        if ((++sp & 255u) == 0u) { if (xb_ld(&bar[XB_TMO])) break; if (sp > XB_SPIN_CAP) { atomicAdd(&bar[XB_TMO], 1u); break; } }
    }
    nloc = mine > 0u ? mine : 1u; nx = cnt > 0u ? cnt : 1u;
}

__device__ __forceinline__ void xcd_barrier(const XcdBarrier& b) {
    asm volatile("s_waitcnt vmcnt(0)" ::: "memory");
    __syncthreads();
    if (threadIdx.x == 0) {
        unsigned* bar = b.bar;
        __builtin_amdgcn_s_waitcnt(0);
        unsigned nloc = b.st[0], nx = b.st[1];
        if (nloc == 0u) { xcd_barrier_complete(bar, b.x, nloc, nx); b.st[0] = nloc; b.st[1] = nx; }
        const unsigned old = xb_add(&bar[XB_XSUB(b.x)], 1u);
        const unsigned gen = old / nloc;
        if (old + 1u == (gen + 1u) * nloc) {
            __builtin_amdgcn_fence(__ATOMIC_RELEASE, "agent");
            asm volatile("s_waitcnt vmcnt(0)" ::: "memory");
            const unsigned og = xb_add(&bar[XB_TOP], 1u);
            const unsigned tg = og / nx;
            if (og + 1u == (tg + 1u) * nx) xb_add(&bar[XB_TOPGEN], 1u);
            else XB_SPIN(xb_ld(&bar[XB_TOPGEN]) == tg, bar);
            __builtin_amdgcn_fence(__ATOMIC_ACQUIRE, "agent");
            xb_add(&bar[XB_XGEN(b.x)], 1u);
            asm volatile("s_waitcnt vmcnt(0)" ::: "memory");
        } else {
            XB_SPIN(xb_ld(&bar[XB_XGEN(b.x)]) == gen, bar);
            __builtin_amdgcn_fence(__ATOMIC_ACQUIRE, "agent");
            asm volatile("s_waitcnt vmcnt(0)" ::: "memory");
        }
    }
    __syncthreads();
}
__device__ __forceinline__ int t5_bucket(int d) {
    if (d < 16) return d < 0 ? 0 : d;
    int b = 16;
    b += (d >= 22); b += (d >= 30); b += (d >= 40); b += (d >= 54); b += (d >= 73); b += (d >= 99); b += (d >= 134); b += (d >= 182);
    b += (d >= 246); b += (d >= 332); b += (d >= 450); b += (d >= 609); b += (d >= 825); b += (d >= 1117); b += (d >= 1513);
    return b;
}
__device__ __forceinline__ void p0_transpose_item(const float* W, const float* g, int K, int N, bf16* WT, int kind, LAS float* scr, int item, int lane) {
    const int nblk = N / 64, kb = item / nblk, nb = item % nblk, k0 = 64 * kb, n0 = 64 * nb;
    float sc = 1.f; if (kind == 3 && ((n0 >= COL_QA && n0 < COL_KA) || (n0 >= COL_QB && n0 < COL_KB))) sc = C2;
    const int lk = lane >> 4, ln = (lane & 15) * 4;
    f32x4 v[16];
#pragma unroll
    for (int i = 0; i < 16; ++i) v[i] = *(const GAS f32x4*)(W + (size_t)(k0 + 4 * i + lk) * N + n0 + ln);
#pragma unroll
    for (int i = 0; i < 16; ++i) { const int kk = 4 * i + lk; const float gk = g ? g[k0 + kk] * sc : sc; LAS float* d = scr + kk * 65 + ln; d[0] = v[i].x * gk; d[1] = v[i].y * gk; d[2] = v[i].z * gk; d[3] = v[i].w * gk; }
    LDS_WAIT(); asm volatile("" ::: "memory");
    int r0 = n0; if (kind == 1) r0 = (n0 / 128) * 256 + (n0 % 128); else if (kind == 2) r0 = (n0 / 128) * 256 + 128 + (n0 % 128);
    const int c = lane & 7;
#pragma unroll
    for (int j = 0; j < 8; ++j) { const int n = (lane >> 3) + 8 * j; const LAS float* s = scr + (8 * c) * 65 + n;
        v4u o; o.x = pk2(s[0 * 65], s[1 * 65]); o.y = pk2(s[2 * 65], s[3 * 65]); o.z = pk2(s[4 * 65], s[5 * 65]); o.w = pk2(s[6 * 65], s[7 * 65]);
        *(GAS v4u*)(WT + (size_t)(r0 + n) * K + k0 + 8 * c) = o; }
    LDS_WAIT(); asm volatile("" ::: "memory");
}

struct Args { const float* in[19]; float* out; unsigned char* ws; int ph_lo, ph_hi; };
constexpr int PH_PRO = 0, PH_L0 = 1, PH_PER_LAYER = 8, PH_FINAL = PH_L0 + DEPTH * PH_PER_LAYER, N_PHASES = PH_FINAL + 1;

__device__ __forceinline__ void attn_naive_item(const bf16* QKV, const float* BT, bf16* OD, bf16* MIX, LAS float* sc, LAS float* qs, int job, int t, int lane) {
    const bool dil = job >= 32; int b, qcol, kcol, vcol, ocol, c; bf16* O;
    if (!dil) { const int m = job & 1, h = (job >> 1) & 3; b = job >> 3; qcol = COL_QA + h * 128 + m * 64; kcol = COL_KA + h * 128 + m * 64; vcol = COL_VA + h * 128; ocol = m * 512 + h * 128; c = h * 2 + m; O = OD; }
    else { const int j = job - 32, h = j & 7; b = j >> 3; qcol = COL_QB + h * 64; kcol = COL_KB + h * 64; vcol = COL_VB + h * 64; ocol = 512 + h * 64; c = 8 + h; O = MIX; }
    const size_t rb = (size_t)b * SEQ;
    qs[lane] = bf2f(QKV[(rb + t) * NQKV + qcol + lane]);
    LDS_WAIT(); asm volatile("" ::: "memory");
    const int lo = dil ? (t > 2048 ? t - 2048 : 0) : 0, n = t - lo + 1;
    const float* bt = BT + c * 4096;
    float mx = -INFINITY;
    for (int kk = lane; kk < n; kk += 64) { const int k = lo + kk; const v4u* kr = (const v4u*)(QKV + (rb + k) * NQKV + kcol); float s = 0.f;
#pragma unroll
        for (int j = 0; j < 8; ++j) { const v4u u = kr[j]; const LAS float* q = qs + j * 8;
            s += q[0] * bf2f(u.x & 0xffff) + q[1] * bf2f(u.x >> 16) + q[2] * bf2f(u.y & 0xffff) + q[3] * bf2f(u.y >> 16) + q[4] * bf2f(u.z & 0xffff) + q[5] * bf2f(u.z >> 16) + q[6] * bf2f(u.w & 0xffff) + q[7] * bf2f(u.w >> 16); }
        s += bt[t - k]; sc[kk] = s; mx = fmaxf(mx, s); }
    mx = wave_max(mx); float l = 0.f;
    for (int kk = lane; kk < n; kk += 64) { const float p = exp2f(sc[kk] - mx); sc[kk] = p; l += p; }
    l = wave_sum(l);
    LDS_WAIT(); asm volatile("" ::: "memory");
    const float il = 1.f / l;
    if (!dil) { float o0 = 0.f, o1 = 0.f;
        for (int kk = 0; kk < n; ++kk) { const float p = sc[kk]; const unsigned u = *(const unsigned*)(QKV + (rb + lo + kk) * NQKV + vcol + 2 * lane); o0 += p * bf2f(u & 0xffff); o1 += p * bf2f(u >> 16); }
        *(unsigned*)(O + (rb + t) * DM + ocol + 2 * lane) = pk2(o0 * il, o1 * il);
    } else { float o0 = 0.f;
        for (int kk = 0; kk < n; ++kk) { const float p = sc[kk]; o0 += p * bf2f(QKV[(rb + lo + kk) * NQKV + vcol + lane]); }
        O[(rb + t) * DM + ocol + lane] = (bf16)f2bf(o0 * il); }
    LDS_WAIT(); asm volatile("" ::: "memory");
}

struct QTab { unsigned char v[128]; };
constexpr QTab make_qtab() { QTab t{}; int cost[128] = {};
    for (int i = 0; i < 128; ++i) { const int kind = i >> 6, qb = i & 15; t.v[i] = (unsigned char)i; const int st = 4 * (qb + 1); cost[i] = kind == 0 ? st * 13 : (st < 36 ? st : 36) * 10; }
    for (int i = 0; i < 128; ++i) { int b = i; for (int j = i + 1; j < 128; ++j) if (cost[j] > cost[b]) b = j; const int c = cost[i]; cost[i] = cost[b]; cost[b] = c; const unsigned char v = t.v[i]; t.v[i] = t.v[b]; t.v[b] = v; }
    return t; }
__constant__ QTab QTAB = make_qtab();
#ifndef REP_GU
#define REP_GU 1
#endif
#ifndef REP_DN
#define REP_DN 1
#endif
#ifndef REP_QKV
#define REP_QKV 1
#endif
#ifndef REP_ATTN
#define REP_ATTN 1
#endif
#ifndef REP_COMB
#define REP_COMB 1
#endif
#ifndef REP_WOUT
#define REP_WOUT 1
#endif
#ifndef REP_PRO
#define REP_PRO 1
#endif
#ifndef MK_NAIVE_ATTN
#define MK_NAIVE_ATTN 0
#endif
__global__ void __launch_bounds__(NWAVES * 64, 2) mk_fwd(Args args) {
    extern __shared__ __attribute__((aligned(16))) unsigned char lds_raw[];
    LAS unsigned char* lds = (LAS unsigned char*)lds_raw;
    volatile LAS unsigned* MISC = (volatile LAS unsigned*)(lds + MISC_OFF);
    const int tid = threadIdx.x, lane = tid & 63, wave = __builtin_amdgcn_readfirstlane(tid >> 6);
    const int G = gridDim.x; const int bx = blockIdx.x; const int vcu = (G % 8 == 0) ? (bx % 8) * (G / 8) + bx / 8 : bx;
    unsigned char* ws = args.ws;
    gu32* ctl = (gu32*)(ws + WS_CTL);
    float* X = args.out; float* BT = (float*)(ws + WS_BT); float* LAM = (float*)(ws + WS_LAM); float* SS = (float*)(ws + WS_SS);
    bf16* W = (bf16*)(ws + WS_W); bf16* XB = (bf16*)(ws + WS_XB); bf16* OD = (bf16*)(ws + WS_OD); bf16* HQ = (bf16*)(ws + WS_HQKV); bf16* MIX = (bf16*)(ws + WS_MIX);
    for (int u = tid; u < (LDS_BYTES - LDSCTL_OFF) / 4; u += NWAVES * 64) ((LAS unsigned*)(lds + LDSCTL_OFF))[u] = 0u;
    __syncthreads();
    const int lo = args.ph_lo, hi = args.ph_hi;
    const bool multi = (hi - lo) > 1;
    XcdBarrier bar; bar.bar = (unsigned*)(ctl + CW_BAR); bar.x = 0; bar.st = nullptr;
    if (multi) bar = xcd_barrier_post((unsigned*)(ctl + CW_BAR), MISC + 8);
#define IN(k) (lo <= (k) && (k) < hi)
#define FRESH_LANE(name) int name = threadIdx.x; asm volatile("" : "+v"(name)); name &= 63
#define SEAM(k) do { if (IN((k) + 1)) xcd_barrier(bar); } while (0)
    const int gw = vcu * NWAVES + wave, NGW = G * NWAVES;

    if (IN(PH_PRO)) {
        for (int i = gw * 64 + lane; i < 16 * 4096; i += NGW * 64) { const int c = i >> 12, d = i & 4095;
            float v = LOG2E * args.in[17][t5_bucket(d) * 16 + c];
            if (c >= 8) { const int mult = (d <= 128 ? 1 : 0) + ((d % 4 == 0 && d <= 512) ? 1 : 0) + ((d % 16 == 0 && d <= 2048) ? 1 : 0); v = mult == 0 ? -INFINITY : v + __builtin_log2f((float)mult); }
            BT[i] = v; }
        if (gw < DEPTH) { const int l = gw; const float a = wave_sum(args.in[7][l * 64 + lane] * args.in[8][l * 64 + lane]), b = wave_sum(args.in[9][l * 64 + lane] * args.in[10][l * 64 + lane]);
            const float lam0 = 0.8f - 0.6f * __expf(-0.3f * (float)l); if (lane == 0) { LAM[l * 2 + 0] = __expf(a) - __expf(b) + lam0; LAM[l * 2 + 1] = 1.0f - lam0; } }
        _Pragma("unroll 1") for (int rep = 0; rep < REP_PRO; ++rep) {
        LAS float* scr = (LAS float*)(lds + RING_OFF + wave * 16640);
        constexpr int I_G = (DM / 64) * (DFF / 64), I_D = (DFF / 64) * (DM / 64), I_IN = (DM / 64) * (NQKV / 64), I_OUT = (DM / 64) * (DM / 64);
        constexpr int I_LAYER = 4 * I_G + 2 * I_D + I_IN + I_OUT;
        for (int it = gw; it < DEPTH * I_LAYER; it += NGW) {
            const int l = it / I_LAYER; int r = it % I_LAYER; bf16* Wl = W + (size_t)l * W_LAYER;
            if (r < I_G) { p0_transpose_item(args.in[2] + (size_t)l * DM * DFF, args.in[1] + l * DM, DM, DFF, Wl + W_GU1, 1, scr, r, lane); continue; } r -= I_G;
            if (r < I_G) { p0_transpose_item(args.in[3] + (size_t)l * DM * DFF, args.in[1] + l * DM, DM, DFF, Wl + W_GU1, 2, scr, r, lane); continue; } r -= I_G;
            if (r < I_D) { p0_transpose_item(args.in[4] + (size_t)l * DFF * DM, nullptr, DFF, DM, Wl + W_D1, 0, scr, r, lane); continue; } r -= I_D;
            if (r < I_IN) { p0_transpose_item(args.in[6] + (size_t)l * DM * NQKV, args.in[5] + l * DM, DM, NQKV, Wl + W_IN, 3, scr, r, lane); continue; } r -= I_IN;
            if (r < I_OUT) { p0_transpose_item(args.in[12] + (size_t)l * DM * DM, nullptr, DM, DM, Wl + W_OUT, 0, scr, r, lane); continue; } r -= I_OUT;
            if (r < I_G) { p0_transpose_item(args.in[14] + (size_t)l * DM * DFF, args.in[13] + l * DM, DM, DFF, Wl + W_GU2, 1, scr, r, lane); continue; } r -= I_G;
            if (r < I_G) { p0_transpose_item(args.in[15] + (size_t)l * DM * DFF, args.in[13] + l * DM, DM, DFF, Wl + W_GU2, 2, scr, r, lane); continue; } r -= I_G;
            p0_transpose_item(args.in[16] + (size_t)l * DFF * DM, nullptr, DFF, DM, Wl + W_D2, 0, scr, r, lane);
        }
        for (int row = gw; row < M; row += NGW) { const GAS f32x4* xr = (const GAS f32x4*)(args.in[0] + (size_t)row * DM) + lane; float s = 0.f; f32x4 v[4];
#pragma unroll
            for (int j = 0; j < 4; ++j) v[j] = xr[64 * j];
#pragma unroll
            for (int j = 0; j < 4; ++j) { s += (v[j].x * v[j].x + v[j].y * v[j].y) + (v[j].z * v[j].z + v[j].w * v[j].w); v2u o; o.x = pk2(v[j].x, v[j].y); o.y = pk2(v[j].z, v[j].w); ((GAS v2u*)(XB + (size_t)row * DM) + lane)[64 * j] = o; }
            s = wave_sum(s); if (lane == 0) *(GAS f32x4*)(SS + (size_t)row * 4) = (f32x4){s, 0.f, 0.f, 0.f}; }
        }
        SEAM(PH_PRO);
    }

#pragma unroll 1
    for (int l = 0; l < DEPTH; ++l) {
        const int pb = PH_L0 + l * PH_PER_LAYER; bf16* Wl = W + (size_t)l * W_LAYER;
#pragma unroll 1
        for (int f = 0; f < 2; ++f) {
            const int pg = pb + (f ? 6 : 0);
            if (f == 1) {
                if (IN(pb + 2)) { _Pragma("unroll 1") for (int rep = 0; rep < REP_QKV; ++rep) { pg8::Gemm g{XB, Wl + W_IN, M, NQKV, DM}; pg8::StaticOrder S; S.init(M, NQKV, G, bx);
                    pg8::EpiQKV E{HQ, NQKV, SS}; pg8::gemm_phase<pg8::EpiQKV, pg8::StaticOrder, true, true>(lds + RING_OFF, g, S, E); } SEAM(pb + 2); }
                if (IN(pb + 3)) {
#if MK_NAIVE_ATTN
                    FRESH_LANE(lane_l);
                    LAS float* sc = (LAS float*)(lds + RING_OFF + wave * 16384); LAS float* qs = (LAS float*)(lds + QS_OFF + wave * 256);
                    for (int i = gw, k = 0; i < 64 * SEQ; i += NGW, ++k) { const int job = i / SEQ, tt = i % SEQ; const int t = (job & 1) ? (SEQ - 1 - tt) : tt;
                        attn_naive_item(HQ, BT, OD, MIX, sc, qs, job, t, lane_l); }
#else
                    int cur_c = -1; const int x0 = (int)(((long)vcu * 8) / G) & 7; gu32* qbase = ctl + CW_Q + l * 8 * 64;
                    _Pragma("unroll 1") for (int rep = 0; rep < REP_ATTN; ++rep)
                    for (int sq = 0; sq < 8; ++sq) { const int xq = (x0 + sq) & 7; gu32* qh = qbase + xq * 64 + rep * 16;
                        if (tid == 0) MISC[12] = __hip_atomic_fetch_add(qh, 1u, RLX_AGENT);
                        __syncthreads(); unsigned idx = (unsigned)__builtin_amdgcn_readfirstlane((int)MISC[12]); __syncthreads();
                        while (idx < 128u) {
                            unsigned nxt = 0u;
                            const unsigned code = QTAB.v[idx]; const int kind = code >> 6, hd = (code >> 4) & 3, qb = code & 15;
                            attn_body::AttnUnit u; u.qb = qb;
                            if (kind == 0) { const int e = 4 * xq + hd, mp = e & 1, h = (e >> 1) & 3; u.b = e >> 3; u.qcol = COL_QA + h * 128 + mp * 64; u.kcol = COL_KA + h * 128 + mp * 64; u.vcol = COL_VA + h * 128;
                                u.ocol = mp * 512 + h * 128; u.c = h * 2 + mp; u.T0 = 0; u.O = (attn_body::bf16*)OD;
                                if (u.c != cur_c) { attn_body::build_bias<128>((char*)lds_raw + RING_OFF, BT, u.c); cur_c = u.c; }
                                attn_body::attn_unit<128, 8>(u, (const attn_body::bf16*)HQ, (char*)lds_raw + RING_OFF, (unsigned*)qh, nxt); }
                            else { const int f = 4 * xq + hd, h = f & 7; u.b = f >> 3; u.qcol = COL_QB + h * 64; u.kcol = COL_KB + h * 64; u.vcol = COL_VB + h * 64; u.ocol = 512 + h * 64; u.c = 8 + h; u.T0 = qb > 8 ? 4 * qb - 32 : 0; u.O = (attn_body::bf16*)MIX;
                                if (u.c != cur_c) { attn_body::build_bias<64>((char*)lds_raw + RING_OFF, BT, u.c); cur_c = u.c; }
                                attn_body::attn_unit<64, 8>(u, (const attn_body::bf16*)HQ, (char*)lds_raw + RING_OFF, (unsigned*)qh, nxt); }
                            if (tid == 0) MISC[12] = nxt;
                            __syncthreads(); idx = (unsigned)__builtin_amdgcn_readfirstlane((int)MISC[12]); __syncthreads();
                        }
                    }
#endif
                    SEAM(pb + 3); }
                if (IN(pb + 4)) { FRESH_LANE(lane_l); const float lam = LAM[2 * l], oml = LAM[2 * l + 1]; const float* gain = args.in[11] + l * 128; const float g0 = gain[lane_l], g1 = gain[lane_l + 64];
                    _Pragma("unroll 1") for (int rep = 0; rep < REP_COMB; ++rep)
                    for (int item = gw; item < M * 4; item += NGW) { const int row = item >> 2, h = item & 3;
                        const bf16* o1 = OD + (size_t)row * DM + h * 128, *o2 = o1 + 512;
                        const float d0 = bf2f(o1[lane_l]) - lam * bf2f(o2[lane_l]), d1 = bf2f(o1[lane_l + 64]) - lam * bf2f(o2[lane_l + 64]);
                        const float r = __builtin_amdgcn_rsqf(wave_sum(d0 * d0 + d1 * d1) * (1.0f / 128.0f) + EPS) * oml;
                        MIX[(size_t)row * DM + h * 128 + lane_l] = (bf16)f2bf(d0 * r * g0); MIX[(size_t)row * DM + h * 128 + lane_l + 64] = (bf16)f2bf(d1 * r * g1); }
                    SEAM(pb + 4); }
                if (IN(pb + 5)) { _Pragma("unroll 1") for (int rep = 0; rep < REP_WOUT; ++rep) { pg8::Gemm g{MIX, Wl + W_OUT, M, DM, DM}; pg8::StaticOrder S; S.init(M, DM, G, bx);
                    pg8::EpiRes E{X, X, XB, SS, rep == REP_WOUT - 1 ? 1.0f : 0.0f, (LAS float*)(lds + EPI_OFF)}; pg8::gemm_phase<pg8::EpiRes, pg8::StaticOrder, false, true>(lds + RING_OFF, g, S, E); } SEAM(pb + 5); }
            }
            if (IN(pg)) { _Pragma("unroll 1") for (int rep = 0; rep < REP_GU; ++rep) { pg8::Gemm g{XB, Wl + (f ? W_GU2 : W_GU1), M, 2 * DFF, DM}; pg8::StaticOrder S; S.init(M, 2 * DFF, G, bx);
                pg8::EpiGU E{HQ, DFF, SS}; pg8::gemm_phase<pg8::EpiGU, pg8::StaticOrder, true, true>(lds + RING_OFF, g, S, E); } SEAM(pg); }
            if (IN(pg + 1)) { _Pragma("unroll 1") for (int rep = 0; rep < REP_DN; ++rep) { pg8::Gemm g{HQ, Wl + (f ? W_D2 : W_D1), M, DM, DFF}; pg8::StaticOrder S; S.init(M, DM, G, bx);
                pg8::EpiRes E{(l == 0 && f == 0) ? args.in[0] : X, X, XB, SS, rep == REP_DN - 1 ? 0.5f : 0.0f, (LAS float*)(lds + EPI_OFF)}; pg8::gemm_phase<pg8::EpiRes, pg8::StaticOrder, false, true>(lds + RING_OFF, g, S, E); } SEAM(pg + 1); }
        }
    }
    if (IN(PH_FINAL)) {
        FRESH_LANE(lane_f); const float* g = args.in[18];
        for (int row = gw; row < M; row += NGW) { GAS f32x4* xr = (GAS f32x4*)(X + (size_t)row * DM) + lane_f; const float r = pg8::rstd_of(SS, row);
#pragma unroll
            for (int j = 0; j < 4; ++j) { const f32x4 v = xr[64 * j]; const f32x4 gg = ((const f32x4*)g + lane_f)[64 * j]; xr[64 * j] = (f32x4){v.x * r * gg.x, v.y * r * gg.y, v.z * r * gg.z, v.w * r * gg.w}; } }
    }
#undef IN
#undef SEAM
}

#ifndef MK_PER_PHASE
#define MK_PER_PHASE 0
#endif
extern "C" void kernel_launch(void* const* d_in, const int* in_sizes, int n_in, void* d_out, int out_size, void* d_ws, size_t ws_size, hipStream_t stream) {
    static int grid = 0;
    if (grid == 0) {
        if (n_in != 19 || in_sizes[0] != M * DM || out_size != M * DM || ws_size < WS_END) { fprintf(stderr, "kernel_launch: unexpected shapes (n_in %d, ws %zu)\n", n_in, ws_size); grid = -1; return; }
        int dev = 0, cus = 0, per_cu = 0;
        if (hipGetDevice(&dev) != hipSuccess || hipDeviceGetAttribute(&cus, hipDeviceAttributeMultiprocessorCount, dev) != hipSuccess) { grid = -1; return; }
        if (hipFuncSetAttribute((const void*)mk_fwd, hipFuncAttributeMaxDynamicSharedMemorySize, LDS_BYTES) != hipSuccess) { fprintf(stderr, "kernel_launch: hipFuncSetAttribute failed\n"); grid = -1; return; }
        if (hipOccupancyMaxActiveBlocksPerMultiprocessor(&per_cu, (const void*)mk_fwd, NWAVES * 64, LDS_BYTES) != hipSuccess || per_cu < 1) { fprintf(stderr, "kernel_launch: occupancy query reports %d workgroups per CU\n", per_cu); (void)hipGetLastError(); grid = -1; return; }
        grid = cus;
    }
    if (grid < 0) return;
    if (hipMemsetAsync((char*)d_ws + WS_CTL, 0, CTL_ZERO_BYTES, stream) != hipSuccess) return;
    Args a{};
    for (int i = 0; i < 19; ++i) a.in[i] = (const float*)d_in[i];
    a.out = (float*)d_out; a.ws = (unsigned char*)d_ws;
#if MK_PER_PHASE
    for (int p = 0; p < N_PHASES; ++p) { a.ph_lo = p; a.ph_hi = p + 1; hipLaunchKernelGGL(mk_fwd, dim3(grid), dim3(NWAVES * 64), LDS_BYTES, stream, a); }
#else
    a.ph_lo = 0; a.ph_hi = N_PHASES;
    hipLaunchKernelGGL(mk_fwd, dim3(grid), dim3(NWAVES * 64), LDS_BYTES, stream, a);
#endif
}
```

```cpp
#include <hip/hip_runtime.h>
#include <cstdio>
#include <cstdint>
#include <cmath>

constexpr int BATCH = 4, SEQ = 4096, DM = 1024, DEPTH = 2, DFF = 2816, NQKV = 3072;
constexpr int M = BATCH * SEQ;
constexpr float EPS = 1e-6f;
constexpr float LOG2E = 1.4426950408889634f;
constexpr float C2 = 0.125f * LOG2E;
constexpr int COL_QA = 0, COL_KA = 512, COL_VA = 1024, COL_QB = 1536, COL_KB = 2048, COL_VB = 2560;

typedef unsigned short bf16;
typedef unsigned v4u __attribute__((ext_vector_type(4)));
typedef unsigned v2u __attribute__((ext_vector_type(2)));

constexpr size_t MiB = 1u << 20;
constexpr size_t WS_CTL = 0, CTL_ZERO_BYTES = 1 * MiB;
constexpr int CW_BAR = 4096;
constexpr size_t WS_BT = 1 * MiB;
constexpr size_t WS_LAM = WS_BT + 16 * 4096 * 4;
constexpr size_t WS_SS = WS_LAM + 4096;
constexpr size_t WS_W = 2 * MiB;
constexpr size_t W_GU1 = 0, W_D1 = W_GU1 + (size_t)2 * DFF * DM, W_IN = W_D1 + (size_t)DM * DFF, W_OUT = W_IN + (size_t)NQKV * DM,
                 W_GU2 = W_OUT + (size_t)DM * DM, W_D2 = W_GU2 + (size_t)2 * DFF * DM, W_LAYER = W_D2 + (size_t)DM * DFF;
constexpr size_t WS_XB = 84 * MiB;
constexpr size_t WS_OD = WS_XB;
constexpr size_t WS_HQKV = 116 * MiB;
constexpr size_t WS_MIX = 212 * MiB;
constexpr size_t WS_END = 244 * MiB;
static_assert(WS_W + 2 * W_LAYER * 2 <= WS_XB, "weights fit");
static_assert(WS_SS + (size_t)M * 16 <= WS_W, "misc fits");

constexpr int LDS_BYTES = 163840;
constexpr int LDSCTL_OFF = LDS_BYTES - 512, MISC_OFF = LDSCTL_OFF + 64;
constexpr int EPI_OFF = LDSCTL_OFF - 4096;
constexpr int QS_OFF = EPI_OFF - 2048;
constexpr int RING_OFF = 0, RING_BYTES = QS_OFF;
static_assert(RING_BYTES >= 131072, "LDS map");
constexpr int CW_Q = 16384;
constexpr int NWAVES = 8;

__device__ __forceinline__ unsigned f2bf(float f) { unsigned u = __builtin_bit_cast(unsigned, f); return (u + 0x7fffu + ((u >> 16) & 1u)) >> 16; }
__device__ __forceinline__ unsigned pk2(float lo, float hi) { return f2bf(lo) | (f2bf(hi) << 16); }
__device__ __forceinline__ float bf2f(unsigned h) { return __builtin_bit_cast(float, h << 16); }
__device__ __forceinline__ float wave_sum(float v) {
#pragma unroll
    for (int o = 1; o < 64; o <<= 1) v += __shfl_xor(v, o);
    return v;
}
__device__ __forceinline__ float wave_max(float v) {
#pragma unroll
    for (int o = 1; o < 64; o <<= 1) v = fmaxf(v, __shfl_xor(v, o));
    return v;
}
namespace pg8 {
#define PG8_LAS __attribute__((address_space(3)))
typedef unsigned short bf16_t;
typedef short bf16x8 __attribute__((ext_vector_type(8)));
typedef float f32x4 __attribute__((ext_vector_type(4)));
typedef unsigned u32x4 __attribute__((ext_vector_type(4)));
constexpr int BM = 256, BK = 64, HALF = 128, HTB = HALF * BK * 2  , STAGE_BYTES = 8 * HTB, NXCD = 8, WGM = 8;

__host__ __device__ __forceinline__ int lds_byte(int r, int c) { const int st = (r >> 4) * 2 + (c >> 5), rr = r & 15, cc = c & 31, ob = rr * 64 + cc * 2; return st * 1024 + (ob ^ (((ob >> 9) & 1) << 5)); }
__host__ __device__ __forceinline__ void stage_rc(int b, int& R, int& C) { const int st = b / 1024, sb = b % 1024, swz = sb ^ (((sb >> 9) & 1) << 5); R = (st >> 1) * 16 + swz / 64; C = (st & 1) * 32 + (swz % 64) / 2; }
__host__ __device__ __forceinline__ int perm32(int rho) { const int n = rho >> 4, i = rho & 15; return 8 * (i >> 2) + 4 * n + (i & 3); }

struct Unit { int pm, pn; };
struct Gemm { const bf16_t* A; const bf16_t* Bt; int M, N, K; };

struct StaticOrder {
    int nM, nN, nwg, G, c;
    __host__ __device__ void init(int M, int N, int G_, int c_) { nM = M / BM; nN = N / BM; nwg = nM * nN; G = G_; c = c_; }
    __host__ __device__ bool next(int i, Unit& u) const {
        const long L = (long)i * G + c; if (L >= nwg) return false;
        int wgid = (int)L; { const int q = nwg / NXCD, r = nwg % NXCD, xcd = wgid % NXCD, off = wgid / NXCD; wgid = (xcd < r ? xcd * (q + 1) : r * (q + 1) + (xcd - r) * q) + off; }
        const int nig = WGM * nN, gid = wgid / nig, fm = gid * WGM, gsz = (nM - fm) < WGM ? (nM - fm) : WGM;
        u.pm = fm + ((wgid % nig) % gsz); u.pn = (wgid % nig) / gsz; return true;
    }
    __device__ __forceinline__ void a_ready(const Unit&) const {}
    __device__ __forceinline__ void done(const Unit&) const {}
};

__device__ __forceinline__ unsigned cvt_pk_bf16(float lo, float hi) { unsigned r; asm volatile("v_cvt_pk_bf16_f32 %0, %1, %2" : "=v"(r) : "v"(lo), "v"(hi)); return r; }
typedef float f32x2 __attribute__((ext_vector_type(2)));
typedef unsigned u32x2w __attribute__((ext_vector_type(2)));
__device__ __forceinline__ __amdgpu_buffer_rsrc_t wt_rsrc(const void* base, unsigned bytes) { return __builtin_amdgcn_make_buffer_rsrc((void*)base, 0, (int)bytes, 0x00020000); }
__device__ __forceinline__ void wt_store16(__amdgpu_buffer_rsrc_t rs, unsigned byte_off, u32x4 v) { __builtin_amdgcn_raw_buffer_store_b128(v, rs, byte_off, 0, 16); }
__device__ __forceinline__ void wt_store8(__amdgpu_buffer_rsrc_t rs, unsigned byte_off, u32x2w v) { __builtin_amdgcn_raw_buffer_store_b64(v, rs, byte_off, 0, 16); }
__device__ __forceinline__ float rstd_of(const float* SS, int row) { const f32x4 s = *(const f32x4*)(SS + (size_t)row * 4); return __builtin_amdgcn_rsqf(((s[0] + s[1]) + (s[2] + s[3])) * (1.0f / 1024.0f) + 1e-6f); }
__device__ __forceinline__ float silu_mul(float g, float u) { return g * u * __builtin_amdgcn_rcpf(1.0f + __builtin_amdgcn_exp2f(-1.4426950408889634f * g)); }
struct EpiGU {
    static constexpr bool PERM = true, AFTER_DRAIN = false;
    bf16_t* H; int ldh; const float* SS;
    __device__ __forceinline__ void operator()(const f32x4 (&acc)[2][2][4][2], const Unit& u, int wr, int wc, int fr, int fq, int wid, int lane, bool tailu) const {
        const int row0 = u.pm * BM + wr * 64 + fr, col0 = u.pn * HALF + wc * 32 + 8 * fq;
        const __amdgpu_buffer_rsrc_t rs = wt_rsrc(H, 16384u * 2816u * 2u);
        float rs_[2][4];
#pragma unroll
        for (int ai = 0; ai < 2; ++ai)
#pragma unroll
            for (int m = 0; m < 4; ++m) rs_[ai][m] = rstd_of(SS, row0 + ai * HALF + m * 16);
#pragma unroll
        for (int ai = 0; ai < 2; ++ai)
#pragma unroll
            for (int m = 0; m < 4; ++m) { const float r = rs_[ai][m]; const f32x4 g0 = acc[ai][0][m][0] * r, g1 = acc[ai][0][m][1] * r, u0 = acc[ai][1][m][0] * r, u1 = acc[ai][1][m][1] * r;
                u32x4 w; w.x = cvt_pk_bf16(silu_mul(g0[0], u0[0]), silu_mul(g0[1], u0[1])); w.y = cvt_pk_bf16(silu_mul(g0[2], u0[2]), silu_mul(g0[3], u0[3]));
                w.z = cvt_pk_bf16(silu_mul(g1[0], u1[0]), silu_mul(g1[1], u1[1])); w.w = cvt_pk_bf16(silu_mul(g1[2], u1[2]), silu_mul(g1[3], u1[3]));
                const unsigned bo = (unsigned)(((row0 + ai * HALF + m * 16) * ldh + col0) * 2); if (tailu) wt_store16(rs, bo, w); else *(u32x4*)((char*)H + bo) = w; }
    }
};
struct EpiQKV {
    static constexpr bool PERM = true, AFTER_DRAIN = false;
    bf16_t* O; int ldc; const float* SS;
    __device__ __forceinline__ void operator()(const f32x4 (&acc)[2][2][4][2], const Unit& u, int wr, int wc, int fr, int fq, int wid, int lane, bool tailu) const {
        const int row0 = u.pm * BM + wr * 64 + fr, col0 = u.pn * BM + wc * 32 + 8 * fq;
        const __amdgpu_buffer_rsrc_t ob = wt_rsrc(O, 16384u * 3072u * 2u);
        float rs[2][4];
#pragma unroll
        for (int ai = 0; ai < 2; ++ai)
#pragma unroll
            for (int m = 0; m < 4; ++m) rs[ai][m] = rstd_of(SS, row0 + ai * HALF + m * 16);
#pragma unroll
        for (int ai = 0; ai < 2; ++ai)
#pragma unroll
            for (int m = 0; m < 4; ++m) { const float r = rs[ai][m]; const unsigned rowb = (unsigned)(((row0 + ai * HALF + m * 16) * ldc + col0) * 2);
#pragma unroll
                for (int bj = 0; bj < 2; ++bj) { const f32x4 v0 = acc[ai][bj][m][0] * r, v1 = acc[ai][bj][m][1] * r;
                    u32x4 w; w.x = cvt_pk_bf16(v0[0], v0[1]); w.y = cvt_pk_bf16(v0[2], v0[3]); w.z = cvt_pk_bf16(v1[0], v1[1]); w.w = cvt_pk_bf16(v1[2], v1[3]);
                    if (tailu) wt_store16(ob, rowb + bj * HALF * 2, w); else *(u32x4*)((char*)O + rowb + bj * HALF * 2) = w; } }
    }
};
struct EpiRes {
    static constexpr bool PERM = false, AFTER_DRAIN = false;
    const float* Xin; float* X; bf16_t* XB; float* SS; float alpha; PG8_LAS float* P;
    __device__ __forceinline__ void operator()(const f32x4 (&acc)[2][2][4][2], const Unit& u, int wr, int wc, int fr, int fq, int wid, int lane, bool tailu) const {
        typedef unsigned u32x2v __attribute__((ext_vector_type(2)));
        const int col0 = u.pn * BM + wc * 32 + 4 * fq;
#pragma unroll
        for (int ai = 0; ai < 2; ++ai)
#pragma unroll
            for (int m = 0; m < 4; ++m) { const int r = ai * HALF + wr * 64 + m * 16 + fr; const size_t off = (size_t)(u.pm * BM + r) * 1024 + col0; float ss = 0.f;
#pragma unroll
                for (int bj = 0; bj < 2; ++bj)
#pragma unroll
                    for (int n = 0; n < 2; ++n) { const size_t o2 = off + bj * HALF + n * 16; const f32x4 xi = *(const f32x4*)(Xin + o2); const f32x4 xo = xi + acc[ai][bj][m][n] * alpha;
                        *(f32x4*)(X + o2) = xo; u32x2v w; w.x = cvt_pk_bf16(xo[0], xo[1]); w.y = cvt_pk_bf16(xo[2], xo[3]); *(u32x2v*)(XB + o2) = w;
                        ss += (xo[0] * xo[0] + xo[1] * xo[1]) + (xo[2] * xo[2] + xo[3] * xo[3]); }
                ss += __shfl_xor(ss, 16); ss += __shfl_xor(ss, 32);
                if (fq == 0) P[r * 4 + wc] = ss;
                if (m & 1) asm volatile("" ::: "memory"); }
        asm volatile("s_waitcnt lgkmcnt(0)" ::: "memory"); __builtin_amdgcn_s_barrier(); asm volatile("" ::: "memory");
        if (wc == 0 && fq == 0) {
#pragma unroll
            for (int ai = 0; ai < 2; ++ai)
#pragma unroll
                for (int m = 0; m < 4; ++m) { const int r = ai * HALF + wr * 64 + m * 16 + fr; const f32x4 p = *(const PG8_LAS f32x4*)(P + r * 4);
                    SS[(size_t)(u.pm * BM + r) * 4 + u.pn] = (p[0] + p[1]) + (p[2] + p[3]); }
        }
    }
};
template <class Epi, class Sched, bool ALIGN_EPI = false, bool SP2 = false>
__device__ __forceinline__ void gemm_phase(PG8_LAS unsigned char* lds, const Gemm g, const Sched& S, const Epi& E) {
    int tid_ = threadIdx.x; asm volatile("" : "+v"(tid_));
    const int tid = tid_, wid = __builtin_amdgcn_readfirstlane(tid >> 6), lane = tid & 63, wr = wid >> 2, wc = wid & 3, fr = lane & 15, fq = lane >> 4;
    const int K = g.K, nt = K / BK;
    unsigned voffA[2], voffB[2];
#pragma unroll
    for (int i = 0; i < 2; ++i) { int R, C; stage_rc(tid * 16 + i * 8192, R, C); const int Rb = Epi::PERM ? ((R & ~31) + perm32(R & 31)) : R;
        voffA[i] = (unsigned)(R * K + C) * 2u; voffB[i] = (unsigned)(Rb * K + C) * 2u; }
    const size_t kstep = (size_t)(BK * 2);
    const size_t hstep = (size_t)HALF * K * 2;
    const size_t tstep = 2 * hstep;
    const unsigned ldsw = (unsigned)wid * 1024u;
    const int aoff = lds_byte(wr * 64 + fr, fq * 8), boff = lds_byte(wc * 32 + fr, fq * 8);
#define PG8_SA(b, h) (((b) * 2 + (h)) * HTB)
#define PG8_SB(b, h) ((4 + (b) * 2 + (h)) * HTB)
#define PG8_STAGE(bufoff, gbase, voff) do { _Pragma("unroll") for (int _i = 0; _i < 2; ++_i) \
        __builtin_amdgcn_global_load_lds((const unsigned*)((const char*)(gbase) + (voff)[_i]), (PG8_LAS unsigned*)(lds + (bufoff) + ldsw + _i * 8192), 16, 0, 0); } while (0)
#define PG8_LDA(dst, b, h) do { _Pragma("unroll") for (int m = 0; m < 4; ++m) _Pragma("unroll") for (int k = 0; k < 2; ++k) dst[m][k] = *(const PG8_LAS bf16x8*)(lds + PG8_SA(b, h) + aoff + m * 2048 + k * 1024); } while (0)
#define PG8_LDB(dst, b, h) do { _Pragma("unroll") for (int n = 0; n < 2; ++n) _Pragma("unroll") for (int k = 0; k < 2; ++k) dst[n][k] = *(const PG8_LAS bf16x8*)(lds + PG8_SB(b, h) + boff + n * 2048 + k * 1024); } while (0)
#define PG8_MMA(ai, bj, At, Bt) do { __builtin_amdgcn_s_setprio(1); _Pragma("unroll") for (int m = 0; m < 4; ++m) _Pragma("unroll") for (int n = 0; n < 2; ++n) _Pragma("unroll") for (int k = 0; k < 2; ++k) \
        acc[ai][bj][m][n] = __builtin_amdgcn_mfma_f32_16x16x32_bf16(Bt[n][k], At[m][k], acc[ai][bj][m][n], 0, 0, 0); __builtin_amdgcn_s_setprio(0); } while (0)
#define PG8_WAIT_V(n) asm volatile("s_waitcnt vmcnt(" #n ")" ::: "memory")
#define PG8_WAIT_L(n) asm volatile("s_waitcnt lgkmcnt(" #n ")" ::: "memory")
#define PG8_BAR __builtin_amdgcn_s_barrier()
#define PG8_SCHED __builtin_amdgcn_sched_barrier(0)
    Unit cur, nxt; int ui = 0;
    if (!S.next(0, cur)) return;
    f32x4 acc[2][2][4][2];
#pragma unroll
    for (int a = 0; a < 2; ++a)
#pragma unroll
        for (int b = 0; b < 2; ++b)
#pragma unroll
            for (int m = 0; m < 4; ++m)
#pragma unroll
                for (int n = 0; n < 2; ++n) acc[a][b][m][n] = (f32x4){0.f, 0.f, 0.f, 0.f};
    bf16x8 At[4][2], B0[2][2], B1[2][2];
    const char* cA = (const char*)g.A + (size_t)cur.pm * tstep; const char* cB = (const char*)g.Bt + (size_t)cur.pn * tstep;
    S.a_ready(cur);
    if constexpr (SP2) {
        PG8_STAGE(PG8_SB(0, 0), cB, voffB); PG8_STAGE(PG8_SB(0, 1), cB + hstep, voffB); PG8_STAGE(PG8_SA(0, 0), cA, voffA); PG8_STAGE(PG8_SA(0, 1), cA + hstep, voffA);
        if (wr == 1) PG8_BAR;
        PG8_WAIT_V(2); PG8_BAR;
        PG8_STAGE(PG8_SB(1, 0), cB + kstep, voffB); PG8_STAGE(PG8_SA(1, 0), cA + kstep, voffA); PG8_STAGE(PG8_SB(1, 1), cB + hstep + kstep, voffB);
        PG8_WAIT_V(6); PG8_BAR;
    } else {
        PG8_STAGE(PG8_SB(0, 0), cB, voffB); PG8_STAGE(PG8_SA(0, 0), cA, voffA); PG8_STAGE(PG8_SB(0, 1), cB + hstep, voffB); PG8_STAGE(PG8_SA(0, 1), cA + hstep, voffA);
        if (wr == 1) PG8_BAR;
        PG8_WAIT_V(4); PG8_BAR;
        PG8_STAGE(PG8_SB(1, 0), cB + kstep, voffB); PG8_STAGE(PG8_SA(1, 0), cA + kstep, voffA); PG8_STAGE(PG8_SB(1, 1), cB + hstep + kstep, voffB);
        PG8_WAIT_V(6); PG8_BAR;
    }
    for (;;) {
        const bool has_next = S.next(ui + 1, nxt);
        const char* nA = has_next ? (const char*)g.A + (size_t)nxt.pm * tstep : cA; const char* nB = has_next ? (const char*)g.Bt + (size_t)nxt.pn * tstep : cB;
        for (int t = 0; t < nt; t += 2) {
            const bool last = (t == nt - 2);
            const char* a1 = cA + (size_t)(t + 1) * kstep;
            const char* a2 = last ? nA : cA + (size_t)(t + 2) * kstep; const char* b2 = last ? nB : cB + (size_t)(t + 2) * kstep;
            const char* a3 = a2 + kstep; const char* b3 = b2 + kstep;
            if (last && has_next) S.a_ready(nxt);
            if constexpr (SP2) {
            PG8_LDB(B0, 0, 0); PG8_LDB(B1, 0, 1); PG8_SCHED; PG8_LDA(At, 0, 0); PG8_STAGE(PG8_SA(1, 1), a1 + hstep, voffA);
            PG8_WAIT_V(8); PG8_WAIT_L(0); PG8_BAR; PG8_MMA(0, 0, At, B0); PG8_MMA(0, 1, At, B1); PG8_BAR; PG8_SCHED;
            PG8_LDA(At, 0, 1); PG8_STAGE(PG8_SB(0, 0), b2, voffB); PG8_STAGE(PG8_SB(0, 1), b2 + hstep, voffB); PG8_STAGE(PG8_SA(0, 0), a2, voffA);
            PG8_WAIT_V(8); PG8_WAIT_L(0); PG8_BAR; PG8_MMA(1, 0, At, B0); PG8_MMA(1, 1, At, B1); PG8_BAR; PG8_SCHED;
            PG8_LDB(B0, 1, 0); PG8_LDB(B1, 1, 1); PG8_SCHED; PG8_LDA(At, 1, 0); PG8_STAGE(PG8_SA(0, 1), a2 + hstep, voffA);
            PG8_WAIT_V(8); PG8_WAIT_L(0); PG8_BAR; PG8_MMA(0, 0, At, B0); PG8_MMA(0, 1, At, B1); PG8_BAR; PG8_SCHED;
            PG8_LDA(At, 1, 1); PG8_STAGE(PG8_SB(1, 0), b3, voffB); PG8_STAGE(PG8_SB(1, 1), b3 + hstep, voffB); PG8_STAGE(PG8_SA(1, 0), a3, voffA);
            PG8_WAIT_V(8); PG8_WAIT_L(0); PG8_BAR; PG8_MMA(1, 0, At, B0); PG8_MMA(1, 1, At, B1); PG8_BAR; PG8_SCHED;
            } else {
            PG8_LDB(B0, 0, 0); PG8_SCHED; PG8_LDA(At, 0, 0); PG8_STAGE(PG8_SA(1, 1), a1 + hstep, voffA);
            PG8_WAIT_L(8); PG8_BAR; PG8_WAIT_L(0); PG8_MMA(0, 0, At, B0); PG8_BAR; PG8_SCHED;
            PG8_LDB(B1, 0, 1); PG8_STAGE(PG8_SB(0, 0), b2, voffB);
            PG8_BAR; PG8_WAIT_L(0); PG8_MMA(0, 1, At, B1); PG8_BAR;
            PG8_LDA(At, 0, 1); PG8_STAGE(PG8_SA(0, 0), a2, voffA);
            PG8_BAR; PG8_WAIT_L(0); PG8_MMA(1, 0, At, B0); PG8_BAR; PG8_SCHED;
            PG8_STAGE(PG8_SB(0, 1), b2 + hstep, voffB);
            PG8_WAIT_V(6); PG8_BAR; PG8_MMA(1, 1, At, B1); PG8_BAR;
            PG8_LDB(B0, 1, 0); PG8_SCHED; PG8_LDA(At, 1, 0); PG8_STAGE(PG8_SA(0, 1), a2 + hstep, voffA);
            PG8_WAIT_L(8); PG8_BAR; PG8_WAIT_L(0); PG8_MMA(0, 0, At, B0); PG8_BAR; PG8_SCHED;
            PG8_LDB(B1, 1, 1); PG8_STAGE(PG8_SB(1, 0), b3, voffB);
            PG8_BAR; PG8_WAIT_L(0); PG8_MMA(0, 1, At, B1); PG8_BAR;
            PG8_LDA(At, 1, 1); PG8_STAGE(PG8_SA(1, 0), a3, voffA);
            PG8_BAR; PG8_WAIT_L(0); PG8_MMA(1, 0, At, B0); PG8_BAR; PG8_SCHED;
            PG8_STAGE(PG8_SB(1, 1), b3 + hstep, voffB);
            PG8_WAIT_V(6); PG8_BAR; PG8_MMA(1, 1, At, B1); PG8_BAR;
            }
        }
        if constexpr (ALIGN_EPI) { if (wr == 0) PG8_BAR; }
        if constexpr (!Epi::AFTER_DRAIN) { Unit u2_; const bool tailu = !S.next(ui + 2, u2_);
            E(acc, cur, wr, wc, fr, fq, wid, lane, tailu); S.done(cur); }
        if (!has_next) break;
#pragma unroll
        for (int a = 0; a < 2; ++a)
#pragma unroll
            for (int b = 0; b < 2; ++b)
#pragma unroll
                for (int m = 0; m < 4; ++m)
#pragma unroll
                    for (int n = 0; n < 2; ++n) acc[a][b][m][n] = (f32x4){0.f, 0.f, 0.f, 0.f};
        cur = nxt; cA = nA; cB = nB; ++ui;
        if constexpr (ALIGN_EPI) { if (wr == 1) PG8_BAR; }
    }
    PG8_WAIT_V(0);
    if constexpr (!ALIGN_EPI) { if (wr == 0) PG8_BAR; }
    PG8_BAR;
    if constexpr (Epi::AFTER_DRAIN) { E.fused(acc, cur, wr, wc, fr, fq, lds, wid, lane); S.done(cur); }
#undef PG8_SA
#undef PG8_SB
#undef PG8_STAGE
#undef PG8_LDA
#undef PG8_LDB
#undef PG8_MMA
#undef PG8_WAIT_V
#undef PG8_WAIT_L
#undef PG8_BAR
#undef PG8_SCHED
}
}
#include <hip/hip_bf16.h>
namespace attn_body {
using bf16=__hip_bfloat16;
using bf16x8=__attribute__((ext_vector_type(8)))short;
using s16x4=__attribute__((ext_vector_type(4)))short;
using f32x16=__attribute__((ext_vector_type(16)))float;
using f32x4v=__attribute__((ext_vector_type(4)))float;
using u32x4=__attribute__((ext_vector_type(4)))unsigned;
constexpr int SEQ=4096,PQ=3072,PO=1024;
constexpr int NW=8,QBLK=32,QB=QBLK*NW,KVBLK=64;
__device__ __forceinline__ int crow(int r,int hi){return (r&3)+8*(r>>2)+4*hi;}
#define SBAR() __builtin_amdgcn_sched_barrier(0)
__device__ __forceinline__ void cmask(f32x16&p0,f32x16&p1,int jb,int qrel,int hi){
  const float NEG=-INFINITY; int kb=64*jb+4*hi;
  #pragma unroll
  for(int r=0;r<16;++r){int kv=kb+(r&3)+8*(r>>2); if(kv>qrel)p0[r]=NEG; if(kv+32>qrel)p1[r]=NEG;}
}
constexpr int NSLOT=3, SLOTB=8192;
constexpr int DTOP=2176, TB_NI=DTOP+320, TB_STRIDE=TB_NI*4+16;
template<int VD> struct Lay {
  static constexpr int VSLOT=SLOTB*(VD/64), LDS_K=0, LDS_V=NSLOT*SLOTB, LDS_WS=LDS_V+NSLOT*VSLOT, LDS_OST=LDS_WS+NW*64*4, LDS_TB=LDS_OST+NW*4096, LDS_BYTES=LDS_TB+4*TB_STRIDE;
};
__device__ __forceinline__ void glds16(const void*gsrc,unsigned lds_dst){unsigned keep;
  asm volatile("s_mov_b32 %0, m0\n\ts_mov_b32 m0, %2\n\ts_nop 0\n\tglobal_load_lds_dwordx4 %1, off\n\ts_mov_b32 m0, %0":"=&s"(keep):"v"(gsrc),"s"(lds_dst):"memory");}
__device__ __forceinline__ float fsub_s(float a,float b){float r;asm("v_sub_f32_e32 %0, %1, %2":"=v"(r):"v"(a),"v"(b));return r;}
typedef float f32x2_t __attribute__((ext_vector_type(2))); typedef __bf16 bf16x2_t __attribute__((ext_vector_type(2)));
__device__ __forceinline__ unsigned cvtpk_s(float lo,float hi){f32x2_t v={lo,hi};bf16x2_t b=__builtin_convertvector(v,bf16x2_t);return __builtin_bit_cast(unsigned,b);}
#define WAIT_BAR(N) asm volatile("s_waitcnt vmcnt(" #N ") lgkmcnt(0)\n\ts_barrier":::"memory")
typedef __attribute__((address_space(3))) const char* lds_cptr;
typedef short v4i16_t __attribute__((ext_vector_type(4)));
__device__ __forceinline__ void kload8(bf16x8*kf,lds_cptr kp){
  kf[0]=*(const __attribute__((address_space(3))) bf16x8*)(kp);      kf[1]=*(const __attribute__((address_space(3))) bf16x8*)(kp+512);
  kf[2]=*(const __attribute__((address_space(3))) bf16x8*)(kp+2048); kf[3]=*(const __attribute__((address_space(3))) bf16x8*)(kp+2560);
  kf[4]=*(const __attribute__((address_space(3))) bf16x8*)(kp+4096); kf[5]=*(const __attribute__((address_space(3))) bf16x8*)(kp+4608);
  kf[6]=*(const __attribute__((address_space(3))) bf16x8*)(kp+6144); kf[7]=*(const __attribute__((address_space(3))) bf16x8*)(kp+6656);
}
__device__ __forceinline__ void kload2(bf16x8*kf,lds_cptr kp,int j){ kf[2*j]=*(const __attribute__((address_space(3))) bf16x8*)(kp+j*2048); kf[2*j+1]=*(const __attribute__((address_space(3))) bf16x8*)(kp+j*2048+512); }
__device__ __forceinline__ s16x4 vtr(lds_cptr p){ return __builtin_bit_cast(s16x4,__builtin_amdgcn_ds_read_tr16_b64_v4i16((__attribute__((address_space(3))) v4i16_t*)p)); }
__device__ __forceinline__ void bload2(f32x16&c,lds_cptr bp,int off,int g){ const f32x4v v=*(const __attribute__((address_space(3))) f32x4v*)(bp+off+32*g); c[4*g]=v[0];c[4*g+1]=v[1];c[4*g+2]=v[2];c[4*g+3]=v[3]; }
__device__ __forceinline__ void bload16(f32x16&c0,f32x16&c1,lds_cptr bp){
  #pragma unroll
  for(int g=0;g<4;++g){bload2(c0,bp,0,g);bload2(c1,bp,128,g);} }
#define MX3(a,b,c) __builtin_fmaxf(__builtin_fmaxf((a),(b)),(c))
__device__ __forceinline__ float rowmax(const f32x16&p0,const f32x16&p1){
  float a=MX3(p0[0],p0[1],p1[0]),b=MX3(p0[2],p0[3],p1[1]);a=MX3(a,p1[2],p1[3]);
  #pragma unroll
  for(int r=4;r<16;r+=4){a=MX3(a,p0[r],p0[r+1]);b=MX3(b,p0[r+2],p0[r+3]);a=MX3(a,p1[r],p1[r+1]);b=MX3(b,p1[r+2],p1[r+3]);}
  float m=__builtin_fmaxf(a,b);
  auto rr=__builtin_amdgcn_permlane32_swap(__float_as_uint(m),__float_as_uint(m),false,false);
  return __builtin_fmaxf(__uint_as_float(rr[0]),__uint_as_float(rr[1]));
}
template<int ND> __device__ __forceinline__ void pv(f32x16*o,int vb,bf16x8 pa0,bf16x8 pa1,bf16x8 pa2,bf16x8 pa3){
  #pragma unroll
  for(int d0=0;d0<ND;++d0){s16x4 lo[4],hi[4];
    #pragma unroll
    for(int ks=0;ks<4;++ks){
      asm volatile("ds_read_b64_tr_b16 %0,%1 offset:%c2":"=&v"(lo[ks]):"v"(vb),"i"(d0*4096+ks*1024):"memory");
      asm volatile("ds_read_b64_tr_b16 %0,%1 offset:%c2":"=&v"(hi[ks]):"v"(vb),"i"(d0*4096+ks*1024+512):"memory");}
    asm volatile("s_waitcnt lgkmcnt(0)":::"memory");SBAR();
    #define PK(k) (bf16x8){lo[k][0],lo[k][1],lo[k][2],lo[k][3],hi[k][0],hi[k][1],hi[k][2],hi[k][3]}
    o[d0]=__builtin_amdgcn_mfma_f32_32x32x16_bf16(pa0,PK(0),o[d0],0,0,0);
    o[d0]=__builtin_amdgcn_mfma_f32_32x32x16_bf16(pa1,PK(1),o[d0],0,0,0);
    o[d0]=__builtin_amdgcn_mfma_f32_32x32x16_bf16(pa2,PK(2),o[d0],0,0,0);
    o[d0]=__builtin_amdgcn_mfma_f32_32x32x16_bf16(pa3,PK(3),o[d0],0,0,0);
    #undef PK
  }
}
struct AttnUnit { int qcol,kcol,vcol,ocol,c,b,qb,T0; bf16* O; };
template<int VD> __device__ __forceinline__ void build_bias(char*shm,const float*BT,int c){
  float*tb=(float*)(shm+Lay<VD>::LDS_TB); const float*bt=BT+c*4096;
  for(int e=threadIdx.x;e<4*TB_NI;e+=NW*64){ const int s=e/TB_NI,i=e-s*TB_NI,d=DTOP-i-s; tb[s*(TB_STRIDE/4)+i]=d>=0?bt[d]:0.f; }
}
template<int N> __device__ __forceinline__ void wait_bar(){ asm volatile("s_waitcnt vmcnt(%0) lgkmcnt(0)\n\ts_barrier"::"n"(N):"memory"); }
template<int VD,int THRL> __device__ __forceinline__ void attn_unit(const AttnUnit&u,const bf16*QKV,char*shm,unsigned*qhead,unsigned&ticket){
  using L=Lay<VD>; constexpr int ND=VD/32, VM=VD/64;
  #define WB(kc,vc) wait_bar<(kc)+(vc)*VM>()
  int tid_=threadIdx.x; asm volatile("":"+v"(tid_));
  const int tid=tid_,lane=tid&63,r32=lane&31,hi=lane>>5; const int wid=__builtin_amdgcn_readfirstlane(tid>>6);
  const long rowbase=(long)u.b*SEQ; const int q0=u.qb*QB;
  const bf16*Qw=QKV+(rowbase+q0+wid*QBLK)*PQ+u.qcol;
  const bf16*Kh=QKV+(rowbase+(long)u.T0*KVBLK)*PQ+u.kcol,*Vh=QKV+(rowbase+(long)u.T0*KVBLK)*PQ+u.vcol;
  const unsigned lds0=(unsigned)(uintptr_t)shm;
  float*wsf=(float*)(shm+L::LDS_WS)+wid*64;
  const bf16*ksrc=Kh+(long)lane*PQ+wid*8;
  const bf16*vsrc=Vh+(long)(16*(wid&3)+(lane>>2))*PQ+(wid>>2)*32+(lane&3)*8;
  const unsigned kdst=lds0+L::LDS_K+wid*1024, vdst=lds0+L::LDS_V+wid*1024;
  #define DMA_K(t,slot) glds16(ksrc+(long)(t)*KVBLK*PQ,(unsigned)__builtin_amdgcn_readfirstlane(kdst+(slot)))
  #define DMA_V(t,slot) do{ _Pragma("unroll") for(int i_=0;i_<VM;++i_) glds16(vsrc+(long)(t)*KVBLK*PQ+64*i_,(unsigned)__builtin_amdgcn_readfirstlane(vdst+(slot)*VM+8192*i_)); }while(0)
  const int vb0=(int)(lds0+L::LDS_V)+((lane>>4)&1)*32+(lane&3)*8+(4*hi+((lane&15)>>2))*64;
  bf16x8 kf[8];
  const lds_cptr shm3=(lds_cptr)shm; const lds_cptr kp0=shm3+L::LDS_K+hi*1024+r32*16; const lds_cptr vp0=shm3+L::LDS_V+((lane>>4)&1)*32+(lane&3)*8+(4*hi+((lane&15)>>2))*64;
  const int NT=(q0+QB)/KVBLK-u.T0;
  const int sft=(4-(r32&3))&3; const lds_cptr tbs=shm3+L::LDS_TB+sft*TB_STRIDE;
  int bnext=DTOP-(q0+wid*QBLK+r32)+KVBLK*u.T0+4*hi-sft;
  #define BPTR() (tbs+4*(bnext>0?bnext:0))
  DMA_K(0,0);DMA_V(0,0);DMA_K(1,SLOTB);
  bf16x8 qr[4];
  #pragma unroll
  for(int d0=0;d0<4;++d0)qr[d0]=*reinterpret_cast<const bf16x8*>(&Qw[(long)r32*PQ+d0*16+hi*8]);
  const lds_cptr qlp=shm3+L::LDS_OST+wid*4096+lane*16; bf16x8 qx=qr[0],qy=qr[1];
  if constexpr(VD==128){
    #pragma unroll
    for(int d0=0;d0<4;++d0)*(__attribute__((address_space(3))) bf16x8*)(shm3+L::LDS_OST+wid*4096+lane*16+d0*1024)=qr[d0]; }
  #define QF(d0) (VD==128?(((d0)&1)?qy:qx):qr[d0])
  #define QLD(d0) do{ if constexpr(VD==128){ (((d0)&1)?qy:qx)=*(const __attribute__((address_space(3))) bf16x8*)(qlp+(d0)*1024); SBAR(); } }while(0)
  float mhat=0.f,l_reg=0.f;f32x16 o[ND];
  #pragma unroll
  for(int d_=0;d_<ND;++d_)o[d_]=f32x16{};
  const int qrel=wid*QBLK+r32;
  #define CMASK(P0,P1,t) do{int jb_=(t)-(NT-4); if(jb_>=0)cmask(P0,P1,jb_,qrel,hi);}while(0)
  bool resc=false;
  #define RESC() do{ if(resc){ asm volatile("s_waitcnt lgkmcnt(0)":::"memory"); \
      _Pragma("unroll") for(int d_=0;d_<ND;++d_) _Pragma("unroll") for(int r=0;r<16;++r)o[d_][r]*=wsf[crow(r,hi)]; } }while(0)
  f32x16 pA0,pA1,pB0,pB1;
  int sl_prev=0,sl_cur=0,sl_next=SLOTB;
  #define ROT() do{sl_prev=sl_cur;sl_cur=sl_next;sl_next=(sl_next==(NSLOT-1)*SLOTB)?0:sl_next+SLOTB;}while(0)
  DMA_K(2,2*SLOTB);
  WB(2,1);
  bload16(pA0,pA1,BPTR()); bnext+=KVBLK;
  { const char*kb=shm+L::LDS_K+hi*1024+r32*16;
    #pragma unroll
    for(int d0=0;d0<4;++d0){ const bf16x8 b0=*reinterpret_cast<const bf16x8*>(kb+d0*2048); const bf16x8 b1=*reinterpret_cast<const bf16x8*>(kb+d0*2048+512);
      pA0=__builtin_amdgcn_mfma_f32_32x32x16_bf16(b0,qr[d0],pA0,0,0,0); pA1=__builtin_amdgcn_mfma_f32_32x32x16_bf16(b1,qr[d0],pA1,0,0,0);} }
  asm volatile("s_nop 15\n\ts_nop 7":"+v"(pA0),"+v"(pA1));CMASK(pA0,pA1,0);
  { const float rm=rowmax(pA0,pA1); mhat=__builtin_fmaxf(rm,-1e30f);
    _Pragma("unroll") for(int r=0;r<16;++r){pA0[r]=__builtin_amdgcn_exp2f(fsub_s(pA0[r],mhat));}
    _Pragma("unroll") for(int r=0;r<16;++r){pA1[r]=__builtin_amdgcn_exp2f(fsub_s(pA1[r],mhat));} }
  WB(0,0);
  DMA_K(3,0);DMA_V(1,SLOTB);
  ROT();
  kload8(kf,kp0+sl_cur);
  bload16(pB0,pB1,BPTR()); bnext+=KVBLK;
  WB(1,1);
  s16x4 vlo[8],vhi[8]; u32x4 pw0,pw1,pw2,pw3;
  #define PKW(P,B) cvtpk_s(P[B],P[B+1])
  #define PAF(k) __builtin_bit_cast(bf16x8,pw##k)
  #define VFR(i) (bf16x8){vlo[i][0],vlo[i][1],vlo[i][2],vlo[i][3],vhi[i][0],vhi[i][1],vhi[i][2],vhi[i][3]}
  #define PIN(x) asm volatile("":"+v"(x))
  #define GAPA(MF,A0,A1,A2,A3,W0,W1,PW) do{ MF; sacc+=A0; sacc+=A1; sacc+=A2; sacc+=A3; PIN(sacc); W0; W1; PIN(PW); SBAR(); }while(0)
  #define EX(v) __builtin_amdgcn_exp2f(fsub_s(v,mhat))
  #define GAPB(MF,X,B) do{ MF; X[B]=EX(X[B]); X[B+1]=EX(X[B+1]); X[B+2]=EX(X[B+2]); X[B+3]=EX(X[B+3]); PIN(X); SBAR(); }while(0)
  #define GAPB2(MF,X,B) do{ MF; X[B]=EX(X[B]); X[B+1]=EX(X[B+1]); PIN(X); SBAR(); }while(0)
  #define VRDF(sl,d0,ks) do{ vlo[sl]=vtr(vp_+((d0)*4096+(ks)*1024)); vhi[sl]=vtr(vp_+((d0)*4096+(ks)*1024+512)); }while(0)
  #define KRD(G,j) do{ if(G){ kload2(kf,kp0+sl_next,j); SBAR(); } }while(0)
  #define BRD(G,P,off,g) do{ if(G){ bload2(P,bp_,off,g); bload2(P,bp_,off,(g)+1); SBAR(); } }while(0)
  #define MF32(a,b,c) __builtin_amdgcn_mfma_f32_32x32x16_bf16(a,b,c,0,0,0)
  #define VA64(j) VRDF(((j)>>1)+4*((j)&1),(j)&1,(j)>>1)
  #define VA128(j) VRDF(j,(j)&3,(j)>>2)
  #define PHASE_A(C0,C1,P0,P1,VA) \
    VA(0); SBAR(); float sacc=(P0[0]+P0[1]); \
    QLD(1); GAPA(C0=MF32(kf[0],QF(0),C0), P0[2],P0[3],P0[4],P0[5],     pw0[0]=PKW(P0,0), pw0[1]=PKW(P0,2), pw0); \
    VA(1); SBAR(); GAPA(C1=MF32(kf[1],QF(0),C1), P0[6],P0[7],P0[8],P0[9],     pw0[2]=PKW(P0,4), pw0[3]=PKW(P0,6), pw0); \
    VA(2); SBAR(); QLD(2); GAPA(C0=MF32(kf[2],QF(1),C0), P0[10],P0[11],P0[12],P0[13], pw1[0]=PKW(P0,8), pw1[1]=PKW(P0,10), pw1); \
    VA(3); SBAR(); GAPA(C1=MF32(kf[3],QF(1),C1), P0[14],P0[15],P1[0],P1[1],   pw1[2]=PKW(P0,12),pw1[3]=PKW(P0,14), pw1); \
    VA(4); SBAR(); QLD(3); GAPA(C0=MF32(kf[4],QF(2),C0), P1[2],P1[3],P1[4],P1[5],     pw2[0]=PKW(P1,0), pw2[1]=PKW(P1,2), pw2); \
    VA(5); SBAR(); GAPA(C1=MF32(kf[5],QF(2),C1), P1[6],P1[7],P1[8],P1[9],     pw2[2]=PKW(P1,4), pw2[3]=PKW(P1,6), pw2); \
    VA(6); SBAR(); GAPA(C0=MF32(kf[6],QF(3),C0), P1[10],P1[11],P1[12],P1[13], pw3[0]=PKW(P1,8), pw3[1]=PKW(P1,10), pw3); \
    VA(7); SBAR(); GAPA(C1=MF32(kf[7],QF(3),C1), P1[14],P1[15],0.f,0.f,       pw3[2]=PKW(P1,12),pw3[3]=PKW(P1,14), pw3); \
    l_reg+=sacc;
  #define DECIDE(C0,C1,t,GK,GV) \
    if(GK){DMA_K((t)+3,sl_cur);} if(GV){DMA_V((t)+1,sl_next);} \
    CMASK(C0,C1,t); \
    { float a=MX3(C0[0],C0[1],C1[0]),b=MX3(C0[2],C0[3],C1[1]); a=MX3(a,C1[2],C1[3]); \
      _Pragma("unroll") for(int r=4;r<16;r+=4){a=MX3(a,C0[r],C0[r+1]);b=MX3(b,C0[r+2],C0[r+3]);a=MX3(a,C1[r],C1[r+1]);b=MX3(b,C1[r+2],C1[r+3]);} \
      float rm=__builtin_fmaxf(a,b); { auto rr=__builtin_amdgcn_permlane32_swap(__float_as_uint(rm),__float_as_uint(rm),false,false); rm=__builtin_fmaxf(__uint_as_float(rr[0]),__uint_as_float(rr[1])); } \
      resc=false; \
      if(__builtin_expect(__any(rm-mhat>(float)THRL),0)){ const float mn=__builtin_fmaxf(rm,mhat); const float f=__builtin_amdgcn_exp2f(mhat-mn); mhat=mn; \
        l_reg*=f; if(hi==0)wsf[r32]=f; resc=true; } } \
    SBAR();
  #define STEP(C0,C1,P0,P1,t,GK,GV,GL) do{ SBAR(); \
    const lds_cptr vp_=vp0+sl_prev*VM; const lds_cptr bp_=BPTR(); \
    if constexpr(VD==64){ \
      PHASE_A(C0,C1,P0,P1,VA64) \
      DECIDE(C0,C1,t,GK,GV) \
      GAPB(o[0]=MF32(PAF(0),VFR(0),o[0]), C0,0); \
      BRD(GL,P0,0,0); GAPB(o[1]=MF32(PAF(0),VFR(4),o[1]), C0,4); \
      KRD(GL,0); GAPB(o[0]=MF32(PAF(1),VFR(1),o[0]), C0,8); \
      KRD(GL,1); GAPB(o[1]=MF32(PAF(1),VFR(5),o[1]), C0,12); \
      KRD(GL,2); GAPB(o[0]=MF32(PAF(2),VFR(2),o[0]), C1,0); \
      KRD(GL,3); GAPB(o[1]=MF32(PAF(2),VFR(6),o[1]), C1,4); \
      BRD(GL,P0,0,2); GAPB(o[0]=MF32(PAF(3),VFR(3),o[0]), C1,8); \
      BRD(GL,P1,128,0); GAPB(o[1]=MF32(PAF(3),VFR(7),o[1]), C1,12); \
      BRD(GL,P1,128,2); \
    } else { \
      PHASE_A(C0,C1,P0,P1,VA128) \
      DECIDE(C0,C1,t,GK,GV) \
        \
      GAPB2(o[0]=MF32(PAF(0),VFR(0),o[0]), C0,0);  VRDF(0,0,2); SBAR(); \
      GAPB2(o[1]=MF32(PAF(0),VFR(1),o[1]), C0,2);  VRDF(1,1,2); SBAR(); \
      GAPB2(o[2]=MF32(PAF(0),VFR(2),o[2]), C0,4);  VRDF(2,2,2); SBAR(); \
      GAPB2(o[3]=MF32(PAF(0),VFR(3),o[3]), C0,6);  VRDF(3,3,2); SBAR(); \
      KRD(GL,0); GAPB2(o[0]=MF32(PAF(1),VFR(4),o[0]), C0,8);  VRDF(4,0,3); SBAR(); \
      KRD(GL,1); GAPB2(o[1]=MF32(PAF(1),VFR(5),o[1]), C0,10); VRDF(5,1,3); SBAR(); \
      KRD(GL,2); GAPB2(o[2]=MF32(PAF(1),VFR(6),o[2]), C0,12); VRDF(6,2,3); SBAR(); \
      KRD(GL,3); GAPB2(o[3]=MF32(PAF(1),VFR(7),o[3]), C0,14); VRDF(7,3,3); SBAR(); \
      BRD(GL,P0,0,0); GAPB2(o[0]=MF32(PAF(2),VFR(0),o[0]), C1,0); \
      BRD(GL,P0,0,2); GAPB2(o[1]=MF32(PAF(2),VFR(1),o[1]), C1,2); \
      BRD(GL,P1,128,0); GAPB2(o[2]=MF32(PAF(2),VFR(2),o[2]), C1,4); \
      BRD(GL,P1,128,2); GAPB2(o[3]=MF32(PAF(2),VFR(3),o[3]), C1,6); \
      GAPB2(o[0]=MF32(PAF(3),VFR(4),o[0]), C1,8); \
      GAPB2(o[1]=MF32(PAF(3),VFR(5),o[1]), C1,10); \
      GAPB2(o[2]=MF32(PAF(3),VFR(6),o[2]), C1,12); \
      QLD(0); GAPB2(o[3]=MF32(PAF(3),VFR(7),o[3]), C1,14); \
    } \
    bnext+=KVBLK; \
    }while(0)
  int t=1;
  #undef CMASK
  #define CMASK(P0,P1,t) do{}while(0)
  for(;t+5<NT;t+=2){
    STEP(pB0,pB1,pA0,pA1,t,true,true,true);     WB(1,1); RESC(); ROT();
    STEP(pA0,pA1,pB0,pB1,t+1,true,true,true);   WB(1,1); RESC(); ROT();
  }
  #undef CMASK
  #define CMASK(P0,P1,t) do{int jb_=(t)-(NT-4); if(jb_>=0)cmask(P0,P1,jb_,qrel,hi);}while(0)
  #define ENDW(tt) do{ if((tt)+3<NT){WB(1,1);} else if((tt)+2<NT){WB(0,1);} else {WB(0,0);} }while(0)
  for(;t+1<NT;t+=2){
    STEP(pB0,pB1,pA0,pA1,t,(t+3<NT),(t+1<NT),(t+1<NT));       ENDW(t);   RESC(); ROT();
    STEP(pA0,pA1,pB0,pB1,t+1,(t+4<NT),(t+2<NT),(t+2<NT));     ENDW(t+1); RESC(); ROT();
  }
  STEP(pB0,pB1,pA0,pA1,NT-1,false,false,false); RESC();
  if(tid==0)ticket=__hip_atomic_fetch_add(qhead,1u,__ATOMIC_RELAXED,__HIP_MEMORY_SCOPE_AGENT);
  { float sacc=pB0[0]+pB0[1]; _Pragma("unroll") for(int r=2;r<16;++r)sacc+=pB0[r]; _Pragma("unroll") for(int r=0;r<16;++r)sacc+=pB1[r]; l_reg+=sacc;
    pw0=(u32x4){PKW(pB0,0),PKW(pB0,2),PKW(pB0,4),PKW(pB0,6)};pw1=(u32x4){PKW(pB0,8),PKW(pB0,10),PKW(pB0,12),PKW(pB0,14)};pw2=(u32x4){PKW(pB1,0),PKW(pB1,2),PKW(pB1,4),PKW(pB1,6)};pw3=(u32x4){PKW(pB1,8),PKW(pB1,10),PKW(pB1,12),PKW(pB1,14)};
    SBAR(); pv<ND>(o,vb0+sl_cur*VM,PAF(0),PAF(1),PAF(2),PAF(3)); }
  {auto rr=__builtin_amdgcn_permlane32_swap(__float_as_uint(l_reg),__float_as_uint(l_reg),false,false);l_reg=__uint_as_float(rr[0])+__uint_as_float(rr[1]);}
  if(hi==0)wsf[32+r32]=l_reg;asm volatile("s_waitcnt lgkmcnt(0)":::"memory");
  float rli[16];
  #pragma unroll
  for(int r=0;r<16;++r)rli[r]=__builtin_amdgcn_rcpf(wsf[32+crow(r,hi)]);
  bf16*Ow=u.O+(rowbase+q0+wid*QBLK)*PO+u.ocol; const __amdgpu_buffer_rsrc_t orsrc=__builtin_amdgcn_make_buffer_rsrc((void*)Ow,0,QBLK*PO*2,0x00020000);
  { bf16*stg=(bf16*)(shm+L::LDS_OST)+wid*2048;
    #pragma unroll
    for(int p=0;p<VM;++p){
      #pragma unroll
      for(int r=0;r<16;++r){const int orow=crow(r,hi);
        #pragma unroll
        for(int d0=0;d0<2;++d0)stg[orow*64+d0*32+r32]=__float2bfloat16(o[2*p+d0][r]*rli[r]);}
      asm volatile("s_waitcnt lgkmcnt(0)":::"memory");
      #pragma unroll
      for(int i=0;i<4;++i){const int row=i*8+(lane>>3),ch=lane&7; const u32x4 v=*(const u32x4*)(stg+row*64+ch*8); __builtin_amdgcn_raw_buffer_store_b128(v,orsrc,(unsigned)((row*PO+p*64+ch*8)*2),0,16);}
      asm volatile("s_waitcnt lgkmcnt(0)":::"memory"); } }
  asm volatile("s_waitcnt lgkmcnt(0)\n\ts_barrier":::"memory");
  #undef PKW
  #undef PAF
  #undef VFR
  #undef PIN
  #undef GAPA
  #undef GAPB
  #undef GAPB2
  #undef EX
  #undef VRDF
  #undef KRD
  #undef BRD
  #undef MF32
  #undef PHASE_A
  #undef QF
  #undef QLD
  #undef VA64
  #undef VA128
  #undef DECIDE
  #undef STEP
  #undef ENDW
  #undef DMA_K
  #undef DMA_V
  #undef CMASK
  #undef RESC
  #undef ROT
  #undef BPTR
  #undef WB
}
constexpr int ATTN_LDS_BYTES=Lay<128>::LDS_BYTES;
#undef SBAR
#undef WAIT_BAR
#undef MX3
}
#define GAS __attribute__((address_space(1)))
#define LAS __attribute__((address_space(3)))
typedef unsigned short bf16;
typedef unsigned v4u __attribute__((ext_vector_type(4)));
typedef float f32x4 __attribute__((ext_vector_type(4)));
typedef short bf16x8 __attribute__((ext_vector_type(8)));
typedef GAS unsigned gu32;
typedef GAS unsigned long long gu64;
#define RLX_AGENT __ATOMIC_RELAXED, __HIP_MEMORY_SCOPE_AGENT
#define LDS_WAIT() asm volatile("s_waitcnt lgkmcnt(0)" ::: "memory")
#define VM_WAIT() asm volatile("s_waitcnt vmcnt(0)" ::: "memory")
__device__ __forceinline__ unsigned long long rt() { return __builtin_amdgcn_s_memrealtime(); }

#define XB_TMO      128
#define XB_XCNT(j)  (256  + 64 * (j))
#define XB_XSUB(j)  (1280 + 64 * (j))
#define XB_XGEN(j)  (2304 + 64 * (j))
#define XB_TOP      3328
#define XB_TOPGEN   3392
#define XCD_BAR_WORDS 3456
#define XB_SPIN_CAP (1u << 18)

__device__ __forceinline__ unsigned xb_ld(unsigned* p)              { return __hip_atomic_load(p, __ATOMIC_RELAXED, __HIP_MEMORY_SCOPE_AGENT); }
__device__ __forceinline__ unsigned xb_add(unsigned* p, unsigned v) { return __hip_atomic_fetch_add(p, v, __ATOMIC_RELAXED, __HIP_MEMORY_SCOPE_AGENT); }
__device__ __forceinline__ unsigned xb_xcc_id() { return (unsigned)__builtin_amdgcn_s_getreg((3 << 11) | 20) & 0xFu; }
#define XB_SPIN(cond, bar) do { unsigned _sp = 0; while (cond) { __builtin_amdgcn_s_sleep(1); \
    if ((++_sp & 255u) == 0u) { if (xb_ld(&(bar)[XB_TMO])) break; if (_sp > XB_SPIN_CAP) { atomicAdd(&(bar)[XB_TMO], 1u); break; } } } } while (0)

struct XcdBarrier {
    unsigned* bar; unsigned x;
    volatile LAS unsigned* st;
};

__device__ __forceinline__ XcdBarrier xcd_barrier_post(unsigned* bar, volatile LAS unsigned* st) {
    XcdBarrier b; b.bar = bar; b.x = xb_xcc_id(); b.st = st;
    if (threadIdx.x == 0) (void)xb_add(&bar[XB_XCNT(b.x)], 1u);
    return b;
}
__device__ __forceinline__ void xcd_barrier_complete(unsigned* bar, unsigned x, unsigned& nloc, unsigned& nx) {
    const unsigned G = gridDim.x * gridDim.y * gridDim.z;
    unsigned sum, cnt, mine, sp = 0u;
    for (;;) {
        sum = 0u; cnt = 0u; mine = 0u;
#pragma unroll
        for (unsigned j = 0; j < 16; ++j) { const unsigned c = xb_ld(&bar[XB_XCNT(j)]); sum += c; cnt += (c > 0u) ? 1u : 0u; mine = (j == x) ? c : mine; }
        if (sum == G) break;
        __builtin_amdgcn_s_sleep(1);
        if ((++sp & 255u) == 0u) { if (xb_ld(&bar[XB_TMO])) break; if (sp > XB_SPIN_CAP) { atomicAdd(&bar[XB_TMO], 1u); break; } }
    }
    nloc = mine > 0u ? mine : 1u; nx = cnt > 0u ? cnt : 1u;
}

__device__ __forceinline__ void xcd_barrier(const XcdBarrier& b) {
    asm volatile("s_waitcnt vmcnt(0)" ::: "memory");
    __syncthreads();
    if (threadIdx.x == 0) {
        unsigned* bar = b.bar;
        __builtin_amdgcn_s_waitcnt(0);
        unsigned nloc = b.st[0], nx = b.st[1];
        if (nloc == 0u) { xcd_barrier_complete(bar, b.x, nloc, nx); b.st[0] = nloc; b.st[1] = nx; }
        const unsigned old = xb_add(&bar[XB_XSUB(b.x)], 1u);
        const unsigned gen = old / nloc;
        if (old + 1u == (gen + 1u) * nloc) {
            __builtin_amdgcn_fence(__ATOMIC_RELEASE, "agent");
            asm volatile("s_waitcnt vmcnt(0)" ::: "memory");
            const unsigned og = xb_add(&bar[XB_TOP], 1u);
            const unsigned tg = og / nx;
            if (og + 1u == (tg + 1u) * nx) xb_add(&bar[XB_TOPGEN], 1u);
            else XB_SPIN(xb_ld(&bar[XB_TOPGEN]) == tg, bar);
            __builtin_amdgcn_fence(__ATOMIC_ACQUIRE, "agent");
            xb_add(&bar[XB_XGEN(b.x)], 1u);
            asm volatile("s_waitcnt vmcnt(0)" ::: "memory");
        } else {
            XB_SPIN(xb_ld(&bar[XB_XGEN(b.x)]) == gen, bar);
            __builtin_amdgcn_fence(__ATOMIC_ACQUIRE, "agent");
            asm volatile("s_waitcnt vmcnt(0)" ::: "memory");
        }
    }
    __syncthreads();
}
__device__ __forceinline__ int t5_bucket(int d) {
    if (d < 16) return d < 0 ? 0 : d;
    int b = 16;
    b += (d >= 22); b += (d >= 30); b += (d >= 40); b += (d >= 54); b += (d >= 73); b += (d >= 99); b += (d >= 134); b += (d >= 182);
    b += (d >= 246); b += (d >= 332); b += (d >= 450); b += (d >= 609); b += (d >= 825); b += (d >= 1117); b += (d >= 1513);
    return b;
}
__device__ __forceinline__ void p0_transpose_item(const float* W, const float* g, int K, int N, bf16* WT, int kind, LAS float* scr, int item, int lane) {
    const int nblk = N / 64, kb = item / nblk, nb = item % nblk, k0 = 64 * kb, n0 = 64 * nb;
    float sc = 1.f; if (kind == 3 && ((n0 >= COL_QA && n0 < COL_KA) || (n0 >= COL_QB && n0 < COL_KB))) sc = C2;
    const int lk = lane >> 4, ln = (lane & 15) * 4;
    f32x4 v[16];
#pragma unroll
    for (int i = 0; i < 16; ++i) v[i] = *(const GAS f32x4*)(W + (size_t)(k0 + 4 * i + lk) * N + n0 + ln);
#pragma unroll
    for (int i = 0; i < 16; ++i) { const int kk = 4 * i + lk; const float gk = g ? g[k0 + kk] * sc : sc; LAS float* d = scr + kk * 65 + ln; d[0] = v[i].x * gk; d[1] = v[i].y * gk; d[2] = v[i].z * gk; d[3] = v[i].w * gk; }
    LDS_WAIT(); asm volatile("" ::: "memory");
    int r0 = n0; if (kind == 1) r0 = (n0 / 128) * 256 + (n0 % 128); else if (kind == 2) r0 = (n0 / 128) * 256 + 128 + (n0 % 128);
    const int c = lane & 7;
#pragma unroll
    for (int j = 0; j < 8; ++j) { const int n = (lane >> 3) + 8 * j; const LAS float* s = scr + (8 * c) * 65 + n;
        v4u o; o.x = pk2(s[0 * 65], s[1 * 65]); o.y = pk2(s[2 * 65], s[3 * 65]); o.z = pk2(s[4 * 65], s[5 * 65]); o.w = pk2(s[6 * 65], s[7 * 65]);
        *(GAS v4u*)(WT + (size_t)(r0 + n) * K + k0 + 8 * c) = o; }
    LDS_WAIT(); asm volatile("" ::: "memory");
}

struct Args { const float* in[19]; float* out; unsigned char* ws; int ph_lo, ph_hi; };
constexpr int I_G = (DM / 64) * (DFF / 64), I_D = (DFF / 64) * (DM / 64), I_IN = (DM / 64) * (NQKV / 64), I_OUT = (DM / 64) * (DM / 64);
constexpr int I_LAYER = 4 * I_G + 2 * I_D + I_IN + I_OUT;
__device__ __forceinline__ void conv_layer_items(const Args& args, bf16* W, LAS float* scr, int lane, int l, int it0, int it1, int step) {
    bf16* Wl = W + (size_t)l * W_LAYER;
    for (int it = it0; it < it1; it += step) { int r = it;
        if (r < I_G) { p0_transpose_item(args.in[2] + (size_t)l * DM * DFF, args.in[1] + l * DM, DM, DFF, Wl + W_GU1, 1, scr, r, lane); continue; } r -= I_G;
        if (r < I_G) { p0_transpose_item(args.in[3] + (size_t)l * DM * DFF, args.in[1] + l * DM, DM, DFF, Wl + W_GU1, 2, scr, r, lane); continue; } r -= I_G;
        if (r < I_D) { p0_transpose_item(args.in[4] + (size_t)l * DFF * DM, nullptr, DFF, DM, Wl + W_D1, 0, scr, r, lane); continue; } r -= I_D;
        if (r < I_IN) { p0_transpose_item(args.in[6] + (size_t)l * DM * NQKV, args.in[5] + l * DM, DM, NQKV, Wl + W_IN, 3, scr, r, lane); continue; } r -= I_IN;
        if (r < I_OUT) { p0_transpose_item(args.in[12] + (size_t)l * DM * DM, nullptr, DM, DM, Wl + W_OUT, 0, scr, r, lane); continue; } r -= I_OUT;
        if (r < I_G) { p0_transpose_item(args.in[14] + (size_t)l * DM * DFF, args.in[13] + l * DM, DM, DFF, Wl + W_GU2, 1, scr, r, lane); continue; } r -= I_G;
        if (r < I_G) { p0_transpose_item(args.in[15] + (size_t)l * DM * DFF, args.in[13] + l * DM, DM, DFF, Wl + W_GU2, 2, scr, r, lane); continue; } r -= I_G;
        p0_transpose_item(args.in[16] + (size_t)l * DFF * DM, nullptr, DFF, DM, Wl + W_D2, 0, scr, r, lane);
    }
}
constexpr int PH_PRO = 0, PH_L0 = 1, PH_PER_LAYER = 8, PH_FINAL = PH_L0 + DEPTH * PH_PER_LAYER, N_PHASES = PH_FINAL + 1;

__device__ __forceinline__ void attn_naive_item(const bf16* QKV, const float* BT, bf16* OD, bf16* MIX, LAS float* sc, LAS float* qs, int job, int t, int lane) {
    const bool dil = job >= 32; int b, qcol, kcol, vcol, ocol, c; bf16* O;
    if (!dil) { const int m = job & 1, h = (job >> 1) & 3; b = job >> 3; qcol = COL_QA + h * 128 + m * 64; kcol = COL_KA + h * 128 + m * 64; vcol = COL_VA + h * 128; ocol = m * 512 + h * 128; c = h * 2 + m; O = OD; }
    else { const int j = job - 32, h = j & 7; b = j >> 3; qcol = COL_QB + h * 64; kcol = COL_KB + h * 64; vcol = COL_VB + h * 64; ocol = 512 + h * 64; c = 8 + h; O = MIX; }
    const size_t rb = (size_t)b * SEQ;
    qs[lane] = bf2f(QKV[(rb + t) * NQKV + qcol + lane]);
    LDS_WAIT(); asm volatile("" ::: "memory");
    const int lo = dil ? (t > 2048 ? t - 2048 : 0) : 0, n = t - lo + 1;
    const float* bt = BT + c * 4096;
    float mx = -INFINITY;
    for (int kk = lane; kk < n; kk += 64) { const int k = lo + kk; const v4u* kr = (const v4u*)(QKV + (rb + k) * NQKV + kcol); float s = 0.f;
#pragma unroll
        for (int j = 0; j < 8; ++j) { const v4u u = kr[j]; const LAS float* q = qs + j * 8;
            s += q[0] * bf2f(u.x & 0xffff) + q[1] * bf2f(u.x >> 16) + q[2] * bf2f(u.y & 0xffff) + q[3] * bf2f(u.y >> 16) + q[4] * bf2f(u.z & 0xffff) + q[5] * bf2f(u.z >> 16) + q[6] * bf2f(u.w & 0xffff) + q[7] * bf2f(u.w >> 16); }
        s += bt[t - k]; sc[kk] = s; mx = fmaxf(mx, s); }
    mx = wave_max(mx); float l = 0.f;
    for (int kk = lane; kk < n; kk += 64) { const float p = exp2f(sc[kk] - mx); sc[kk] = p; l += p; }
    l = wave_sum(l);
    LDS_WAIT(); asm volatile("" ::: "memory");
    const float il = 1.f / l;
    if (!dil) { float o0 = 0.f, o1 = 0.f;
        for (int kk = 0; kk < n; ++kk) { const float p = sc[kk]; const unsigned u = *(const unsigned*)(QKV + (rb + lo + kk) * NQKV + vcol + 2 * lane); o0 += p * bf2f(u & 0xffff); o1 += p * bf2f(u >> 16); }
        *(unsigned*)(O + (rb + t) * DM + ocol + 2 * lane) = pk2(o0 * il, o1 * il);
    } else { float o0 = 0.f;
        for (int kk = 0; kk < n; ++kk) { const float p = sc[kk]; o0 += p * bf2f(QKV[(rb + lo + kk) * NQKV + vcol + lane]); }
        O[(rb + t) * DM + ocol + lane] = (bf16)f2bf(o0 * il); }
    LDS_WAIT(); asm volatile("" ::: "memory");
}

struct QTab { unsigned char v[128]; };
constexpr QTab make_qtab() { QTab t{}; int cost[128] = {};
    for (int i = 0; i < 128; ++i) { const int kind = i >> 6, qb = i & 15; t.v[i] = (unsigned char)i; const int st = 4 * (qb + 1); cost[i] = kind == 0 ? st * 13 : (st < 36 ? st : 36) * 10; }
    for (int i = 0; i < 128; ++i) { int b = i; for (int j = i + 1; j < 128; ++j) if (cost[j] > cost[b]) b = j; const int c = cost[i]; cost[i] = cost[b]; cost[b] = c; const unsigned char v = t.v[i]; t.v[i] = t.v[b]; t.v[b] = v; }
    return t; }
__constant__ QTab QTAB = make_qtab();
#ifndef REP_GU
#define REP_GU 1
#endif
#ifndef REP_DN
#define REP_DN 1
#endif
#ifndef REP_QKV
#define REP_QKV 1
#endif
#ifndef REP_ATTN
#define REP_ATTN 1
#endif
#ifndef REP_COMB
#define REP_COMB 1
#endif
#ifndef REP_WOUT
#define REP_WOUT 1
#endif
#ifndef REP_PRO
#define REP_PRO 1
#endif
#ifndef MK_NAIVE_ATTN
#define MK_NAIVE_ATTN 0
#endif
__global__ void __launch_bounds__(NWAVES * 64, 2) mk_fwd(Args args) {
    extern __shared__ __attribute__((aligned(16))) unsigned char lds_raw[];
    LAS unsigned char* lds = (LAS unsigned char*)lds_raw;
    volatile LAS unsigned* MISC = (volatile LAS unsigned*)(lds + MISC_OFF);
    const int tid = threadIdx.x, lane = tid & 63, wave = __builtin_amdgcn_readfirstlane(tid >> 6);
    const int G = gridDim.x; const int bx = blockIdx.x; const int vcu = (G % 8 == 0) ? (bx % 8) * (G / 8) + bx / 8 : bx;
    unsigned char* ws = args.ws;
    gu32* ctl = (gu32*)(ws + WS_CTL);
    float* X = args.out; float* BT = (float*)(ws + WS_BT); float* LAM = (float*)(ws + WS_LAM); float* SS = (float*)(ws + WS_SS);
    bf16* W = (bf16*)(ws + WS_W); bf16* XB = (bf16*)(ws + WS_XB); bf16* OD = (bf16*)(ws + WS_OD); bf16* HQ = (bf16*)(ws + WS_HQKV); bf16* MIX = (bf16*)(ws + WS_MIX);
    for (int u = tid; u < (LDS_BYTES - LDSCTL_OFF) / 4; u += NWAVES * 64) ((LAS unsigned*)(lds + LDSCTL_OFF))[u] = 0u;
    __syncthreads();
    const int lo = args.ph_lo, hi = args.ph_hi;
    const bool multi = (hi - lo) > 1;
    XcdBarrier bar; bar.bar = (unsigned*)(ctl + CW_BAR); bar.x = 0; bar.st = nullptr;
    if (multi) bar = xcd_barrier_post((unsigned*)(ctl + CW_BAR), MISC + 8);
#define IN(k) (lo <= (k) && (k) < hi)
#define FRESH_LANE(name) int name = threadIdx.x; asm volatile("" : "+v"(name)); name &= 63
#define SEAM(k) do { if (IN((k) + 1)) xcd_barrier(bar); } while (0)
    const int gw = vcu * NWAVES + wave, NGW = G * NWAVES;

    if (IN(PH_PRO)) {
        for (int i = gw * 64 + lane; i < 16 * 4096; i += NGW * 64) { const int c = i >> 12, d = i & 4095;
            float v = LOG2E * args.in[17][t5_bucket(d) * 16 + c];
            if (c >= 8) { const int mult = (d <= 128 ? 1 : 0) + ((d % 4 == 0 && d <= 512) ? 1 : 0) + ((d % 16 == 0 && d <= 2048) ? 1 : 0); v = mult == 0 ? -INFINITY : v + __builtin_log2f((float)mult); }
            BT[i] = v; }
        if (gw < DEPTH) { const int l = gw; const float a = wave_sum(args.in[7][l * 64 + lane] * args.in[8][l * 64 + lane]), b = wave_sum(args.in[9][l * 64 + lane] * args.in[10][l * 64 + lane]);
            const float lam0 = 0.8f - 0.6f * __expf(-0.3f * (float)l); if (lane == 0) { LAM[l * 2 + 0] = __expf(a) - __expf(b) + lam0; LAM[l * 2 + 1] = 1.0f - lam0; } }
        _Pragma("unroll 1") for (int rep = 0; rep < REP_PRO; ++rep) {
        conv_layer_items(args, W, (LAS float*)(lds + RING_OFF + wave * 16640), lane, 0, gw, I_LAYER, NGW);
        for (int row = gw; row < M; row += NGW) { const GAS f32x4* xr = (const GAS f32x4*)(args.in[0] + (size_t)row * DM) + lane; float s = 0.f; f32x4 v[4];
#pragma unroll
            for (int j = 0; j < 4; ++j) v[j] = xr[64 * j];
#pragma unroll
            for (int j = 0; j < 4; ++j) { s += (v[j].x * v[j].x + v[j].y * v[j].y) + (v[j].z * v[j].z + v[j].w * v[j].w); v2u o; o.x = pk2(v[j].x, v[j].y); o.y = pk2(v[j].z, v[j].w); ((GAS v2u*)(XB + (size_t)row * DM) + lane)[64 * j] = o; }
            s = wave_sum(s); if (lane == 0) *(GAS f32x4*)(SS + (size_t)row * 4) = (f32x4){s, 0.f, 0.f, 0.f}; }
        }
        SEAM(PH_PRO);
    }

#pragma unroll 1
    for (int l = 0; l < DEPTH; ++l) {
        const int pb = PH_L0 + l * PH_PER_LAYER; bf16* Wl = W + (size_t)l * W_LAYER;
#pragma unroll 1
        for (int f = 0; f < 2; ++f) {
            const int pg = pb + (f ? 6 : 0);
            if (f == 1) {
                if (IN(pb + 2)) { _Pragma("unroll 1") for (int rep = 0; rep < REP_QKV; ++rep) { pg8::Gemm g{XB, Wl + W_IN, M, NQKV, DM}; pg8::StaticOrder S; S.init(M, NQKV, G, bx);
                    pg8::EpiQKV E{HQ, NQKV, SS}; pg8::gemm_phase<pg8::EpiQKV, pg8::StaticOrder, true, true>(lds + RING_OFF, g, S, E); } SEAM(pb + 2); }
                if (IN(pb + 3)) {
#if MK_NAIVE_ATTN
                    FRESH_LANE(lane_l);
                    LAS float* sc = (LAS float*)(lds + RING_OFF + wave * 16384); LAS float* qs = (LAS float*)(lds + QS_OFF + wave * 256);
                    for (int i = gw, k = 0; i < 64 * SEQ; i += NGW, ++k) { const int job = i / SEQ, tt = i % SEQ; const int t = (job & 1) ? (SEQ - 1 - tt) : tt;
                        attn_naive_item(HQ, BT, OD, MIX, sc, qs, job, t, lane_l); }
#else
                    int cur_c = -1; const int x0 = (int)(((long)vcu * 8) / G) & 7; gu32* qbase = ctl + CW_Q + l * 8 * 64;
                    _Pragma("unroll 1") for (int rep = 0; rep < REP_ATTN; ++rep)
                    for (int sq = 0; sq < 8; ++sq) { const int xq = (x0 + sq) & 7; gu32* qh = qbase + xq * 64 + rep * 16;
                        if (tid == 0) MISC[12] = __hip_atomic_fetch_add(qh, 1u, RLX_AGENT);
                        __syncthreads(); unsigned idx = (unsigned)__builtin_amdgcn_readfirstlane((int)MISC[12]); __syncthreads();
                        while (idx < 128u) {
                            unsigned nxt = 0u;
                            const unsigned code = QTAB.v[idx]; const int kind = code >> 6, hd = (code >> 4) & 3, qb = code & 15;
                            attn_body::AttnUnit u; u.qb = qb;
                            if (kind == 0) { const int e = 4 * xq + hd, mp = e & 1, h = (e >> 1) & 3; u.b = e >> 3; u.qcol = COL_QA + h * 128 + mp * 64; u.kcol = COL_KA + h * 128 + mp * 64; u.vcol = COL_VA + h * 128;
                                u.ocol = mp * 512 + h * 128; u.c = h * 2 + mp; u.T0 = 0; u.O = (attn_body::bf16*)OD;
                                if (u.c != cur_c) { attn_body::build_bias<128>((char*)lds_raw + RING_OFF, BT, u.c); cur_c = u.c; }
                                attn_body::attn_unit<128, 8>(u, (const attn_body::bf16*)HQ, (char*)lds_raw + RING_OFF, (unsigned*)qh, nxt); }
                            else { const int f = 4 * xq + hd, h = f & 7; u.b = f >> 3; u.qcol = COL_QB + h * 64; u.kcol = COL_KB + h * 64; u.vcol = COL_VB + h * 64; u.ocol = 512 + h * 64; u.c = 8 + h; u.T0 = qb > 8 ? 4 * qb - 32 : 0; u.O = (attn_body::bf16*)MIX;
                                if (u.c != cur_c) { attn_body::build_bias<64>((char*)lds_raw + RING_OFF, BT, u.c); cur_c = u.c; }
                                attn_body::attn_unit<64, 8>(u, (const attn_body::bf16*)HQ, (char*)lds_raw + RING_OFF, (unsigned*)qh, nxt); }
                            if (tid == 0) MISC[12] = nxt;
                            __syncthreads(); idx = (unsigned)__builtin_amdgcn_readfirstlane((int)MISC[12]); __syncthreads();
                        }
                    }
#endif
                    SEAM(pb + 3); }
                if (IN(pb + 4)) { FRESH_LANE(lane_l); const float lam = LAM[2 * l], oml = LAM[2 * l + 1]; const float* gain = args.in[11] + l * 128; const float g0 = gain[lane_l], g1 = gain[lane_l + 64];
                    _Pragma("unroll 1") for (int rep = 0; rep < REP_COMB; ++rep)
                    for (int item = gw; item < M * 4; item += NGW) { const int row = item >> 2, h = item & 3;
                        const bf16* o1 = OD + (size_t)row * DM + h * 128, *o2 = o1 + 512;
                        const float d0 = bf2f(o1[lane_l]) - lam * bf2f(o2[lane_l]), d1 = bf2f(o1[lane_l + 64]) - lam * bf2f(o2[lane_l + 64]);
                        const float r = __builtin_amdgcn_rsqf(wave_sum(d0 * d0 + d1 * d1) * (1.0f / 128.0f) + EPS) * oml;
                        MIX[(size_t)row * DM + h * 128 + lane_l] = (bf16)f2bf(d0 * r * g0); MIX[(size_t)row * DM + h * 128 + lane_l + 64] = (bf16)f2bf(d1 * r * g1); }
                    SEAM(pb + 4); }
                if (IN(pb + 5)) { _Pragma("unroll 1") for (int rep = 0; rep < REP_WOUT; ++rep) { pg8::Gemm g{MIX, Wl + W_OUT, M, DM, DM}; pg8::StaticOrder S; S.init(M, DM, G, bx);
                    pg8::EpiRes E{X, X, XB, SS, rep == REP_WOUT - 1 ? 1.0f : 0.0f, (LAS float*)(lds + EPI_OFF)}; pg8::gemm_phase<pg8::EpiRes, pg8::StaticOrder, false, true>(lds + RING_OFF, g, S, E); } SEAM(pb + 5); }
            }
            if (IN(pg)) { _Pragma("unroll 1") for (int rep = 0; rep < REP_GU; ++rep) { pg8::Gemm g{XB, Wl + (f ? W_GU2 : W_GU1), M, 2 * DFF, DM}; pg8::StaticOrder S; S.init(M, 2 * DFF, G, bx);
                pg8::EpiGU E{HQ, DFF, SS}; pg8::gemm_phase<pg8::EpiGU, pg8::StaticOrder, true, true>(lds + RING_OFF, g, S, E); }
                if (l + 1 < DEPTH) {
                    const int nwg_ = (M / 256) * (2 * DFF / 256), rounds_ = (nwg_ + G - 1) / G, busy_ = nwg_ - (rounds_ - 1) * G; int nidle = G - busy_, rank = bx - busy_; if (nidle == 0) { nidle = G; rank = bx; }
                    if (rank >= 0) { FRESH_LANE(lane_c); const int h0 = f ? I_LAYER / 2 : 0, h1 = f ? I_LAYER : I_LAYER / 2;
                        conv_layer_items(args, W, (LAS float*)(lds + RING_OFF + wave * 16640), lane_c, l + 1, h0 + rank * NWAVES + wave, h1, nidle * NWAVES); } }
                SEAM(pg); }
            if (IN(pg + 1)) { _Pragma("unroll 1") for (int rep = 0; rep < REP_DN; ++rep) { pg8::Gemm g{HQ, Wl + (f ? W_D2 : W_D1), M, DM, DFF}; pg8::StaticOrder S; S.init(M, DM, G, bx);
                pg8::EpiRes E{(l == 0 && f == 0) ? args.in[0] : X, X, XB, SS, rep == REP_DN - 1 ? 0.5f : 0.0f, (LAS float*)(lds + EPI_OFF)}; pg8::gemm_phase<pg8::EpiRes, pg8::StaticOrder, false, true>(lds + RING_OFF, g, S, E); } SEAM(pg + 1); }
        }
    }
    if (IN(PH_FINAL)) {
        FRESH_LANE(lane_f); const float* g = args.in[18];
        for (int row = gw; row < M; row += NGW) { GAS f32x4* xr = (GAS f32x4*)(X + (size_t)row * DM) + lane_f; const float r = pg8::rstd_of(SS, row);
#pragma unroll
            for (int j = 0; j < 4; ++j) { const f32x4 v = xr[64 * j]; const f32x4 gg = ((const f32x4*)g + lane_f)[64 * j]; xr[64 * j] = (f32x4){v.x * r * gg.x, v.y * r * gg.y, v.z * r * gg.z, v.w * r * gg.w}; } }
    }
#undef IN
#undef SEAM
}

#ifndef MK_PER_PHASE
#define MK_PER_PHASE 0
#endif
extern "C" void kernel_launch(void* const* d_in, const int* in_sizes, int n_in, void* d_out, int out_size, void* d_ws, size_t ws_size, hipStream_t stream) {
    static int grid = 0;
    if (grid == 0) {
        if (n_in != 19 || in_sizes[0] != M * DM || out_size != M * DM || ws_size < WS_END) { fprintf(stderr, "kernel_launch: unexpected shapes (n_in %d, ws %zu)\n", n_in, ws_size); grid = -1; return; }
        int dev = 0, cus = 0, per_cu = 0;
        if (hipGetDevice(&dev) != hipSuccess || hipDeviceGetAttribute(&cus, hipDeviceAttributeMultiprocessorCount, dev) != hipSuccess) { grid = -1; return; }
        if (hipFuncSetAttribute((const void*)mk_fwd, hipFuncAttributeMaxDynamicSharedMemorySize, LDS_BYTES) != hipSuccess) { fprintf(stderr, "kernel_launch: hipFuncSetAttribute failed\n"); grid = -1; return; }
        if (hipOccupancyMaxActiveBlocksPerMultiprocessor(&per_cu, (const void*)mk_fwd, NWAVES * 64, LDS_BYTES) != hipSuccess || per_cu < 1) { fprintf(stderr, "kernel_launch: occupancy query reports %d workgroups per CU\n", per_cu); (void)hipGetLastError(); grid = -1; return; }
        grid = cus;
    }
    if (grid < 0) return;
    if (hipMemsetAsync((char*)d_ws + WS_CTL, 0, CTL_ZERO_BYTES, stream) != hipSuccess) return;
    Args a{};
    for (int i = 0; i < 19; ++i) a.in[i] = (const float*)d_in[i];
    a.out = (float*)d_out; a.ws = (unsigned char*)d_ws;
#if MK_PER_PHASE
    for (int p = 0; p < N_PHASES; ++p) { a.ph_lo = p; a.ph_hi = p + 1; hipLaunchKernelGGL(mk_fwd, dim3(grid), dim3(NWAVES * 64), LDS_BYTES, stream, a); }
#else
    a.ph_lo = 0; a.ph_hi = N_PHASES;
    hipLaunchKernelGGL(mk_fwd, dim3(grid), dim3(NWAVES * 64), LDS_BYTES, stream, a);
#endif
}
```
